# Optimizing an MI355X kernel written in HIP

```python
import math
import jax, jax.numpy as jnp
from jax import lax
import numpy as np

D_MODEL = 1024
BATCH = 4
SEQ = 4096
DEPTH = 1

DA_HEADS = 8
DA_HEAD_DIM = 64
DA_V_DIM = 2 * DA_HEAD_DIM
DA_QK_WIDTH = DA_HEADS * 2 * DA_HEAD_DIM
DA_WIDTH = DA_HEADS * DA_V_DIM
ROPE_DIM = DA_HEAD_DIM // 4
ROPE_THETA = 500000.0
Q_BLOCK = 128
ML_HEADS = 8
ML_QK_DIM = 64
ML_V_DIM = 128
ML_QK_WIDTH = ML_HEADS * ML_QK_DIM
ML_V_WIDTH = ML_HEADS * ML_V_DIM
CONV_WIDTH = 4
CHUNK = 64
N_BRANCH = 2
D_FF = 4 * D_MODEL
EPS = 1e-6
SPLIT_SIZES = (DA_QK_WIDTH, DA_QK_WIDTH, DA_WIDTH,
               ML_QK_WIDTH, ML_QK_WIDTH, ML_V_WIDTH, ML_HEADS, ML_HEADS, ML_V_WIDTH,
               N_BRANCH * D_MODEL)
D_IN = sum(SPLIT_SIZES)

kernel_name = "hybrid_diffattn_mlstm_gated_block"


def rms_norm(x, w):
    x32 = x.astype(jnp.float32)
    y = x32 * lax.rsqrt(jnp.mean(x32 * x32, axis=-1, keepdims=True) + EPS)
    return (y * w.astype(jnp.float32)).astype(x.dtype)


def rope_tables(positions):
    inv = ROPE_THETA ** (-jnp.arange(0, ROPE_DIM, 2, dtype=jnp.float32) / ROPE_DIM)
    ang = positions.astype(jnp.float32)[..., None] * inv
    return jnp.cos(ang), jnp.sin(ang)


def apply_partial_rope(x, cos, sin):
    half = ROPE_DIM // 2
    xr = x[..., :ROPE_DIM].astype(jnp.float32)
    x1, x2 = xr[..., :half], xr[..., half:]
    c = cos[:, :, None, None, :]
    s = sin[:, :, None, None, :]
    rot = jnp.concatenate([x1 * c - x2 * s, x2 * c + x1 * s], axis=-1)
    return jnp.concatenate([rot.astype(x.dtype), x[..., ROPE_DIM:]], axis=-1)


def diff_attention(q, k, v, lam, cos, sin):
    B, S = q.shape[0], q.shape[1]
    H, d, dv = DA_HEADS, DA_HEAD_DIM, DA_V_DIM
    q = apply_partial_rope(q, cos, sin).astype(jnp.float32) * (d ** -0.5)
    k = apply_partial_rope(k, cos, sin).astype(jnp.float32)
    q = q.transpose(0, 2, 3, 1, 4)
    k = k.transpose(0, 2, 3, 1, 4)
    v32 = v.astype(jnp.float32).transpose(0, 2, 1, 3)
    nblk = S // Q_BLOCK
    qb = jnp.moveaxis(q.reshape(B, H, 2, nblk, Q_BLOCK, d), 3, 0)
    kpos = jnp.arange(S)

    def block(args):
        q_blk, j = args
        s = jnp.einsum('bhcqd,bhckd->bhcqk', q_blk, k)
        qpos = j * Q_BLOCK + jnp.arange(Q_BLOCK)
        mask = kpos[None, :] <= qpos[:, None]
        p = jax.nn.softmax(jnp.where(mask, s, -jnp.inf), axis=-1)
        a = p[:, :, 0] - lam * p[:, :, 1]
        return jnp.einsum('bhqk,bhkv->bhqv', a, v32)

    o = lax.map(block, (qb, jnp.arange(nblk)))
    o = jnp.moveaxis(o, 0, 2).reshape(B, H, S, dv)
    return o.transpose(0, 2, 1, 3)


def causal_dwconv(u, w, b):
    S = u.shape[1]
    up = jnp.pad(u, ((0, 0), (CONV_WIDTH - 1, 0), (0, 0)))
    out = b
    for j in range(CONV_WIDTH):
        out = out + up[:, j:j + S] * w[j]
    return out


def mlstm_chunkwise(q, k, v, i_pre, f_pre):
    B, H, S, dk = q.shape
    dv = v.shape[-1]
    L = CHUNK
    NC = S // L
    q = q * (dk ** -0.5)
    logf = jax.nn.log_sigmoid(f_pre)

    def chunks(a):
        return jnp.moveaxis(a.reshape((B, H, NC, L) + a.shape[3:]), 2, 0)

    qc, kc, vc, ic = chunks(q), chunks(k), chunks(v), chunks(i_pre)
    bc = jnp.cumsum(chunks(logf), axis=-1)
    tri = jnp.tril(jnp.ones((L, L), dtype=bool))

    def step(carry, inp):
        C, n, m = carry
        qb, kb, vb, ib, bb = inp
        D = jnp.where(tri, bb[..., :, None] - bb[..., None, :] + ib[..., None, :], -jnp.inf)
        m_inter = bb + m[..., None]
        m_t = jnp.maximum(jnp.max(D, axis=-1), m_inter)
        dexp = jnp.exp(D - m_t[..., None])
        inter = jnp.exp(m_inter - m_t)
        s = jnp.einsum('bhtd,bhsd->bhts', qb, kb) * dexp
        num = jnp.einsum('bhts,bhsv->bhtv', s, vb) + inter[..., None] * jnp.einsum('bhtd,bhdv->bhtv', qb, C)
        den = jnp.sum(s, axis=-1) + inter * jnp.einsum('bhtd,bhd->bht', qb, n)
        h = num / jnp.maximum(jnp.abs(den), jnp.exp(-m_t))[..., None]
        b_last = bb[..., -1]
        w_log = b_last[..., None] - bb + ib
        m_new = jnp.maximum(b_last + m, jnp.max(w_log, axis=-1))
        decay = jnp.exp(b_last + m - m_new)
        ws = jnp.exp(w_log - m_new[..., None])
        C_new = decay[..., None, None] * C + jnp.einsum('bhs,bhsd,bhsv->bhdv', ws, kb, vb)
        n_new = decay[..., None] * n + jnp.einsum('bhs,bhsd->bhd', ws, kb)
        return (C_new, n_new, m_new), h

    init = (jnp.zeros((B, H, dk, dv), jnp.float32), jnp.zeros((B, H, dk), jnp.float32),
            jnp.zeros((B, H), jnp.float32))
    _, hs = lax.scan(step, init, (qc, kc, vc, ic, bc))
    return jnp.moveaxis(hs, 0, 2).reshape(B, H, S, dv)


def setup_inputs(seed: int = 0) -> dict:
    key = jax.random.key(seed)
    ks = jax.random.split(key, 20)
    f32 = jnp.float32
    nrm = lambda k, shape, scale: jax.random.normal(k, shape, f32) * scale
    x = jax.random.normal(ks[0], (BATCH, SEQ, D_MODEL), f32)
    positions = jnp.broadcast_to(jnp.arange(SEQ, dtype=jnp.int32), (BATCH, SEQ))
    gate_b_i = nrm(ks[1], (DEPTH, ML_HEADS), 0.1)
    gate_b_f = jnp.linspace(3.0, 6.0, ML_HEADS, dtype=f32)[None, :] + nrm(ks[2], (DEPTH, ML_HEADS), 0.1)
    return {
        "x": x,
        "positions": positions,
        "norm_mix_w": 1.0 + nrm(ks[3], (DEPTH, D_MODEL), 0.02),
        "w_in": nrm(ks[4], (DEPTH, D_MODEL, D_IN), D_MODEL ** -0.5),
        "ml_gate_b": jnp.concatenate([gate_b_i, gate_b_f], axis=-1),
        "conv_w": nrm(ks[5], (DEPTH, CONV_WIDTH, 2 * ML_QK_WIDTH), CONV_WIDTH ** -0.5),
        "conv_b": nrm(ks[6], (DEPTH, 2 * ML_QK_WIDTH), 0.01),
        "da_lambda": nrm(ks[7], (DEPTH, 4, DA_HEAD_DIM), 0.1),
        "da_subln_w": 1.0 + nrm(ks[8], (DEPTH, DA_V_DIM), 0.02),
        "ml_norm_w": 1.0 + nrm(ks[9], (DEPTH, ML_V_WIDTH), 0.02),
        "w_proj_a": nrm(ks[10], (DEPTH, DA_WIDTH, D_MODEL), DA_WIDTH ** -0.5),
        "w_proj_b": nrm(ks[11], (DEPTH, ML_V_WIDTH, D_MODEL), ML_V_WIDTH ** -0.5),
        "w_out": nrm(ks[12], (DEPTH, D_MODEL, D_MODEL), D_MODEL ** -0.5),
        "norm_ffn_w": 1.0 + nrm(ks[13], (DEPTH, D_MODEL), 0.02),
        "w_ff1": nrm(ks[14], (DEPTH, D_MODEL, D_FF), D_MODEL ** -0.5),
        "w_ff2": nrm(ks[15], (DEPTH, D_FF, D_MODEL), D_FF ** -0.5),
        "final_norm_w": 1.0 + nrm(ks[16], (D_MODEL,), 0.02),
    }


def reference(x, positions, norm_mix_w, w_in, ml_gate_b, conv_w, conv_b, da_lambda,
              da_subln_w, ml_norm_w, w_proj_a, w_proj_b, w_out, norm_ffn_w, w_ff1,
              w_ff2, final_norm_w):
    B, S, _ = x.shape
    cos, sin = rope_tables(positions)
    split_idx = [int(c) for c in np.cumsum(SPLIT_SIZES)[:-1]]
    h = x
    for l in range(DEPTH):
        lambda_init = 0.8 - 0.6 * math.exp(-0.3 * l)
        xn = rms_norm(h, norm_mix_w[l])
        proj = jnp.einsum('bsd,de->bse', xn, w_in[l])
        (da_q, da_k, da_v, ml_q, ml_k, ml_v, ml_i, ml_f, ml_o, gate_pre) = jnp.split(proj, split_idx, axis=-1)

        lam_p = da_lambda[l].astype(jnp.float32)
        lam = (jnp.exp(jnp.sum(lam_p[0] * lam_p[1])) - jnp.exp(jnp.sum(lam_p[2] * lam_p[3]))
               + lambda_init)
        qa = da_q.reshape(B, S, DA_HEADS, 2, DA_HEAD_DIM)
        ka = da_k.reshape(B, S, DA_HEADS, 2, DA_HEAD_DIM)
        va = da_v.reshape(B, S, DA_HEADS, DA_V_DIM)
        oa = diff_attention(qa, ka, va, lam, cos, sin)
        oa = rms_norm(oa, da_subln_w[l]) * (1.0 - lambda_init)
        ya = jnp.einsum('bse,ed->bsd', oa.reshape(B, S, DA_WIDTH).astype(x.dtype), w_proj_a[l])

        qk = jax.nn.silu(causal_dwconv(jnp.concatenate([ml_q, ml_k], axis=-1), conv_w[l], conv_b[l]))
        qm = qk[..., :ML_QK_WIDTH].reshape(B, S, ML_HEADS, ML_QK_DIM).transpose(0, 2, 1, 3)
        km = qk[..., ML_QK_WIDTH:].reshape(B, S, ML_HEADS, ML_QK_DIM).transpose(0, 2, 1, 3)
        vm = ml_v.reshape(B, S, ML_HEADS, ML_V_DIM).transpose(0, 2, 1, 3)
        i_pre = (ml_i + ml_gate_b[l, :ML_HEADS]).transpose(0, 2, 1)
        f_pre = (ml_f + ml_gate_b[l, ML_HEADS:]).transpose(0, 2, 1)
        hm = mlstm_chunkwise(qm.astype(jnp.float32), km.astype(jnp.float32), vm.astype(jnp.float32),
                             i_pre.astype(jnp.float32), f_pre.astype(jnp.float32))
        hm = hm.transpose(0, 2, 1, 3)
        hm = rms_norm(hm, ml_norm_w[l].reshape(ML_HEADS, ML_V_DIM)).reshape(B, S, ML_V_WIDTH)
        ob = (jax.nn.sigmoid(ml_o.astype(jnp.float32)) * hm).astype(x.dtype)
        yb = jnp.einsum('bse,ed->bsd', ob, w_proj_b[l])

        g = jax.nn.sigmoid(gate_pre.astype(jnp.float32)).reshape(B, S, N_BRANCH, D_MODEL).astype(x.dtype)
        merged = g[:, :, 0] * ya + g[:, :, 1] * yb
        h = h + jnp.einsum('bsd,de->bse', merged, w_out[l])

        hn = rms_norm(h, norm_ffn_w[l])
        u = jax.nn.relu(jnp.einsum('bsd,df->bsf', hn, w_ff1[l]))
        h = h + jnp.einsum('bsf,fd->bsd', u * u, w_ff2[l])
    return rms_norm(h, final_norm_w)
```

```cpp
#include <hip/hip_runtime.h>
#include <cstdio>
#include <cstdint>
namespace pg8 {
#define PG8_LAS __attribute__((address_space(3)))
typedef unsigned short bf16_t;
typedef short bf16x8 __attribute__((ext_vector_type(8)));
typedef float f32x4 __attribute__((ext_vector_type(4)));
typedef unsigned u32x4 __attribute__((ext_vector_type(4)));
constexpr int BM = 256, BK = 64, HALF = 128, HTB = HALF * BK * 2  , STAGE_BYTES = 8 * HTB, NXCD = 8, WGM = 8;

__host__ __device__ __forceinline__ int lds_byte(int r, int c) { const int st = (r >> 4) * 2 + (c >> 5), rr = r & 15, cc = c & 31, ob = rr * 64 + cc * 2; return st * 1024 + (ob ^ (((ob >> 9) & 1) << 5)); }
__host__ __device__ __forceinline__ void stage_rc(int b, int& R, int& C) { const int st = b / 1024, sb = b % 1024, swz = sb ^ (((sb >> 9) & 1) << 5); R = (st >> 1) * 16 + swz / 64; C = (st & 1) * 32 + (swz % 64) / 2; }
__host__ __device__ __forceinline__ int perm32(int rho) { const int n = rho >> 4, i = rho & 15; return 8 * (i >> 2) + 4 * n + (i & 3); }

struct Unit { int pm, pn; };
struct Gemm { const bf16_t* A; const bf16_t* Bt; int M, N, K; const bf16_t* A2; int pn_split; };

struct StaticOrder {
    int nM, nN, nwg, G, c;
    __host__ __device__ void init(int M, int N, int G_, int c_) { nM = M / BM; nN = N / BM; nwg = nM * nN; G = G_; c = c_; }
    __host__ __device__ bool next(int i, Unit& u) const {
        const long L = (long)i * G + c; if (L >= nwg) return false;
        int wgid = (int)L; { const int q = nwg / NXCD, r = nwg % NXCD, xcd = wgid % NXCD, off = wgid / NXCD; wgid = (xcd < r ? xcd * (q + 1) : r * (q + 1) + (xcd - r) * q) + off; }
        const int nig = WGM * nN, gid = wgid / nig, fm = gid * WGM, gsz = (nM - fm) < WGM ? (nM - fm) : WGM;
        u.pm = fm + ((wgid % nig) % gsz); u.pn = (wgid % nig) / gsz; return true;
    }
    __device__ __forceinline__ void a_ready(const Unit&) const {}
    __device__ __forceinline__ void done(const Unit&) const {}
};

__device__ __forceinline__ unsigned cvt_pk_bf16(float lo, float hi) { unsigned r; asm volatile("v_cvt_pk_bf16_f32 %0, %1, %2" : "=v"(r) : "v"(lo), "v"(hi)); return r; }
typedef float f32x2 __attribute__((ext_vector_type(2)));
__device__ __forceinline__ f32x2 gelu_pk(f32x2 v) {
    const f32x2 av = __builtin_elementwise_abs(v), d = av * 0.2316418882f + 1.0f;
    f32x2 t; t.x = __builtin_amdgcn_rcpf(d.x); t.y = __builtin_amdgcn_rcpf(d.y);
    f32x2 q = t * 0.5307027145f + (-0.7265760135f); q = q * t + 0.7107068705f; q = q * t + (-0.142248368f); q = q * t + 0.127414796f; q = q * t;
    const f32x2 s = (v * v) * (-0.72134752044f);
    f32x2 e; e.x = __builtin_amdgcn_exp2f(s.x); e.y = __builtin_amdgcn_exp2f(s.y);
    const f32x2 m = v * (q * e), r = v - m;
    f32x2 o; o.x = v.x < 0.f ? m.x : r.x; o.y = v.y < 0.f ? m.y : r.y; return o;
}

template <int ACT  > struct EpiBf16 {
    static constexpr bool PERM = true, AFTER_DRAIN = false; static_assert(ACT == 0 || ACT == 1, "EpiBf16: ACT is 0 (none) or 1 (gelu_pk)");
    bf16_t* O; int ldc; const float* bias; int split_cols; size_t split_stride; float scale0;
    __device__ __forceinline__ void operator()(const f32x4 (&acc)[2][2][4][2], const Unit& u, int wr, int wc, int fr, int fq) const {
        const int row0 = u.pm * BM + wr * 64 + fr; int colt = u.pn * BM; bf16_t* base = O;
        float sc = 1.f; if (split_cols) { const int t = colt / split_cols; base += (size_t)t * split_stride; colt -= t * split_cols; if (t == 0) sc = scale0; }
        const int col0 = colt + wc * 32 + 8 * fq, bcol0 = u.pn * BM + wc * 32 + 8 * fq;
        f32x4 bv[2][2];
#pragma unroll
        for (int bj = 0; bj < 2; ++bj)
#pragma unroll
            for (int n = 0; n < 2; ++n) bv[bj][n] = bias ? *(const f32x4*)(bias + bcol0 + bj * HALF + 4 * n) : (f32x4){0.f, 0.f, 0.f, 0.f};
#pragma unroll
        for (int ai = 0; ai < 2; ++ai)
#pragma unroll
            for (int m = 0; m < 4; ++m) { bf16_t* rowp = base + (size_t)(row0 + ai * HALF + m * 16) * ldc + col0;
#pragma unroll
                for (int bj = 0; bj < 2; ++bj) { f32x4 v0 = acc[ai][bj][m][0] + bv[bj][0], v1 = acc[ai][bj][m][1] + bv[bj][1];
                    if (ACT == 1) { f32x2 a = gelu_pk((f32x2){v0[0], v0[1]}), b = gelu_pk((f32x2){v0[2], v0[3]}), c = gelu_pk((f32x2){v1[0], v1[1]}), d = gelu_pk((f32x2){v1[2], v1[3]});
                        v0 = (f32x4){a.x, a.y, b.x, b.y}; v1 = (f32x4){c.x, c.y, d.x, d.y}; }
                    v0 = v0 * sc; v1 = v1 * sc; u32x4 w; w.x = cvt_pk_bf16(v0[0], v0[1]); w.y = cvt_pk_bf16(v0[2], v0[3]); w.z = cvt_pk_bf16(v1[0], v1[1]); w.w = cvt_pk_bf16(v1[2], v1[3]);
                    *(u32x4*)(rowp + bj * HALF) = w; } }
    }
};


__device__ __forceinline__ float sigm(float x) { return __builtin_amdgcn_rcpf(1.f + __builtin_amdgcn_exp2f(-1.4426950408889634f * x)); }
__device__ __forceinline__ float bf_lo(unsigned w) { return __uint_as_float(w << 16); }
__device__ __forceinline__ float bf_hi(unsigned w) { return __uint_as_float(w & 0xffff0000u); }

struct EpiInProj {
    static constexpr bool PERM = true, AFTER_DRAIN = false;
    bf16_t* base0; size_t bufstride; const float* rope; float qscale;
    __device__ __forceinline__ void operator()(const f32x4 (&acc)[2][2][4][2], const Unit& u, int wr, int wc, int fr, int fq) const {
        const int buf = u.pn >> 2; bf16_t* base = base0 + (size_t)buf * bufstride;
        const int row0 = u.pm * BM + wr * 64 + fr, col0 = (u.pn & 3) * 256 + wc * 32 + 8 * fq;
        const bool ropew = (buf < 2) && ((wc & 1) == 0);
        const float sc = (buf == 0) ? qscale : 1.f;
#pragma unroll
        for (int ai = 0; ai < 2; ++ai)
#pragma unroll
            for (int m = 0; m < 4; ++m) {
                const int row = row0 + ai * HALF + m * 16; bf16_t* rowp = base + (size_t)row * 1024 + col0;
                f32x4 c0 = {1.f, 1.f, 1.f, 1.f}, c1 = c0, s0 = {0.f, 0.f, 0.f, 0.f}, s1 = s0;
                if (ropew) { const f32x4* rp = (const f32x4*)(rope + (size_t)row * 16); c0 = rp[0]; c1 = rp[1]; s0 = rp[2]; s1 = rp[3]; }
#pragma unroll
                for (int bj = 0; bj < 2; ++bj) {
                    f32x4 v0 = acc[ai][bj][m][0], v1 = acc[ai][bj][m][1];
                    if (ropew) {
                        f32x4 p0, p1;
#pragma unroll
                        for (int e = 0; e < 4; ++e) { p0[e] = __shfl_xor(v0[e], 16); p1[e] = __shfl_xor(v1[e], 16); }
                        if (fq == 0) { v0 = v0 * c0 - p0 * s0; v1 = v1 * c1 - p1 * s1; }
                        else if (fq == 1) { v0 = v0 * c0 + p0 * s0; v1 = v1 * c1 + p1 * s1; }
                    }
                    v0 = v0 * sc; v1 = v1 * sc;
                    u32x4 w; w.x = cvt_pk_bf16(v0[0], v0[1]); w.y = cvt_pk_bf16(v0[2], v0[3]); w.z = cvt_pk_bf16(v1[0], v1[1]); w.w = cvt_pk_bf16(v1[2], v1[3]);
                    *(u32x4*)(rowp + bj * HALF) = w;
                }
            }
    }
};
struct EpiSigMul {
    static constexpr bool PERM = true, AFTER_DRAIN = false;
    bf16_t* O; int ldc;
    __device__ __forceinline__ void operator()(const f32x4 (&acc)[2][2][4][2], const Unit& u, int wr, int wc, int fr, int fq) const {
        const int row0 = u.pm * BM + wr * 64 + fr, col0 = u.pn * BM + wc * 32 + 8 * fq;
#pragma unroll
        for (int ai = 0; ai < 2; ++ai)
#pragma unroll
            for (int m = 0; m < 4; ++m) {
                bf16_t* rowp = O + (size_t)(row0 + ai * HALF + m * 16) * ldc + col0;
#pragma unroll
                for (int bj = 0; bj < 2; ++bj) {
                    const u32x4 old = *(const u32x4*)(rowp + bj * HALF);
                    const f32x4 v0 = acc[ai][bj][m][0], v1 = acc[ai][bj][m][1];
                    u32x4 w;
                    w.x = cvt_pk_bf16(sigm(v0[0]) * bf_lo(old.x), sigm(v0[1]) * bf_hi(old.x));
                    w.y = cvt_pk_bf16(sigm(v0[2]) * bf_lo(old.y), sigm(v0[3]) * bf_hi(old.y));
                    w.z = cvt_pk_bf16(sigm(v1[0]) * bf_lo(old.z), sigm(v1[1]) * bf_hi(old.z));
                    w.w = cvt_pk_bf16(sigm(v1[2]) * bf_lo(old.w), sigm(v1[3]) * bf_hi(old.w));
                    *(u32x4*)(rowp + bj * HALF) = w;
                }
            }
    }
};
struct EpiFF1 {
    static constexpr bool PERM = true, AFTER_DRAIN = false;
    bf16_t* O; int ldc; const float* ss; float eps;
    __device__ __forceinline__ void operator()(const f32x4 (&acc)[2][2][4][2], const Unit& u, int wr, int wc, int fr, int fq) const {
        const int row0 = u.pm * BM + wr * 64 + fr, col0 = u.pn * BM + wc * 32 + 8 * fq;
#pragma unroll
        for (int ai = 0; ai < 2; ++ai)
#pragma unroll
            for (int m = 0; m < 4; ++m) {
                const int row = row0 + ai * HALF + m * 16; bf16_t* rowp = O + (size_t)row * ldc + col0;
                const f32x4 q = *(const f32x4*)(ss + (size_t)row * 4);
                const float rstd = __builtin_amdgcn_rsqf(((q[0] + q[1]) + (q[2] + q[3])) * (1.0f / 1024.0f) + eps);
#pragma unroll
                for (int bj = 0; bj < 2; ++bj) {
                    f32x4 v0 = acc[ai][bj][m][0] * rstd, v1 = acc[ai][bj][m][1] * rstd;
#pragma unroll
                    for (int e = 0; e < 4; ++e) { const float a = fmaxf(v0[e], 0.f), b = fmaxf(v1[e], 0.f); v0[e] = a * a; v1[e] = b * b; }
                    u32x4 w; w.x = cvt_pk_bf16(v0[0], v0[1]); w.y = cvt_pk_bf16(v0[2], v0[3]); w.z = cvt_pk_bf16(v1[0], v1[1]); w.w = cvt_pk_bf16(v1[2], v1[3]);
                    *(u32x4*)(rowp + bj * HALF) = w;
                }
            }
    }
};
struct EpiRes {
    static constexpr bool PERM = false, AFTER_DRAIN = true;
    const float* base; float* out; bf16_t* outb; float* ss;
    __device__ __forceinline__ void fused(f32x4 (&acc)[2][2][4][2], const Unit& u, int wr, int wc, int fr, int fq, PG8_LAS unsigned char* lds, int wid, int lane) const {
        typedef unsigned u32x2v __attribute__((ext_vector_type(2)));
        PG8_LAS float* P = (PG8_LAS float*)lds;
        const int col0 = u.pn * BM + wc * 32 + 4 * fq;
#pragma unroll
        for (int ai = 0; ai < 2; ++ai)
#pragma unroll
            for (int m = 0; m < 4; ++m) {
                const int r = ai * HALF + wr * 64 + m * 16 + fr; const size_t off = (size_t)(u.pm * BM + r) * 1024 + col0; float s = 0.f;
#pragma unroll
                for (int bj = 0; bj < 2; ++bj)
#pragma unroll
                    for (int n = 0; n < 2; ++n) {
                        const f32x4 bs = *(const f32x4*)(base + off + bj * HALF + n * 16); const f32x4 o = bs + acc[ai][bj][m][n];
                        *(f32x4*)(out + off + bj * HALF + n * 16) = o; s += (o[0] * o[0] + o[1] * o[1]) + (o[2] * o[2] + o[3] * o[3]);
                        if (outb) { u32x2v w; w.x = cvt_pk_bf16(o[0], o[1]); w.y = cvt_pk_bf16(o[2], o[3]); *(u32x2v*)(outb + off + bj * HALF + n * 16) = w; }
                    }
                s += __shfl_xor(s, 16); s += __shfl_xor(s, 32);
                if (fq == 0) P[r * 4 + wc] = s;
                if (m & 1) asm volatile("" ::: "memory");
            }
        asm volatile("s_waitcnt lgkmcnt(0)" ::: "memory"); __builtin_amdgcn_s_barrier(); asm volatile("" ::: "memory");
        const int tid = wid * 64 + lane;
        if (tid < 256) { const float t = (P[tid * 4 + 0] + P[tid * 4 + 1]) + (P[tid * 4 + 2] + P[tid * 4 + 3]); ss[(size_t)(u.pm * BM + tid) * 4 + u.pn] = t; }
        asm volatile("s_waitcnt lgkmcnt(0)" ::: "memory"); __builtin_amdgcn_s_barrier(); asm volatile("" ::: "memory");
    }
};
template <class Epi, class Sched, bool ALIGN_EPI = false, bool SP2 = false>
__device__ __forceinline__ void gemm_phase(PG8_LAS unsigned char* lds, const Gemm g, const Sched& S, const Epi& E) {
    const int tid = threadIdx.x, wid = __builtin_amdgcn_readfirstlane(tid >> 6), lane = tid & 63, wr = wid >> 2, wc = wid & 3, fr = lane & 15, fq = lane >> 4;
    const int K = g.K, nt = K / BK;
    unsigned voffA[2], voffB[2];
#pragma unroll
    for (int i = 0; i < 2; ++i) { int R, C; stage_rc(tid * 16 + i * 8192, R, C); const int Rb = Epi::PERM ? ((R & ~31) + perm32(R & 31)) : R;
        voffA[i] = (unsigned)(R * K + C) * 2u; voffB[i] = (unsigned)(Rb * K + C) * 2u; }
    const size_t kstep = (size_t)(BK * 2);
    const size_t hstep = (size_t)HALF * K * 2;
    const size_t tstep = 2 * hstep;
    const unsigned ldsw = (unsigned)wid * 1024u;
    const int aoff = lds_byte(wr * 64 + fr, fq * 8), boff = lds_byte(wc * 32 + fr, fq * 8);
#define PG8_SA(b, h) (((b) * 2 + (h)) * HTB)
#define PG8_SB(b, h) ((4 + (b) * 2 + (h)) * HTB)
#define PG8_STAGE(bufoff, gbase, voff) do { _Pragma("unroll") for (int _i = 0; _i < 2; ++_i) \
        __builtin_amdgcn_global_load_lds((const unsigned*)((const char*)(gbase) + (voff)[_i]), (PG8_LAS unsigned*)(lds + (bufoff) + ldsw + _i * 8192), 16, 0, 0); } while (0)
#define PG8_LDA(dst, b, h) do { _Pragma("unroll") for (int m = 0; m < 4; ++m) _Pragma("unroll") for (int k = 0; k < 2; ++k) dst[m][k] = *(const PG8_LAS bf16x8*)(lds + PG8_SA(b, h) + aoff + m * 2048 + k * 1024); } while (0)
#define PG8_LDB(dst, b, h) do { _Pragma("unroll") for (int n = 0; n < 2; ++n) _Pragma("unroll") for (int k = 0; k < 2; ++k) dst[n][k] = *(const PG8_LAS bf16x8*)(lds + PG8_SB(b, h) + boff + n * 2048 + k * 1024); } while (0)
#define PG8_MMA(ai, bj, At, Bt) do { __builtin_amdgcn_s_setprio(1); _Pragma("unroll") for (int m = 0; m < 4; ++m) _Pragma("unroll") for (int n = 0; n < 2; ++n) _Pragma("unroll") for (int k = 0; k < 2; ++k) \
        acc[ai][bj][m][n] = __builtin_amdgcn_mfma_f32_16x16x32_bf16(Bt[n][k], At[m][k], acc[ai][bj][m][n], 0, 0, 0); __builtin_amdgcn_s_setprio(0); } while (0)
#define PG8_WAIT_V(n) asm volatile("s_waitcnt vmcnt(" #n ")" ::: "memory")
#define PG8_WAIT_L(n) asm volatile("s_waitcnt lgkmcnt(" #n ")" ::: "memory")
#define PG8_BAR __builtin_amdgcn_s_barrier()
#define PG8_SCHED __builtin_amdgcn_sched_barrier(0)
    Unit cur, nxt; int ui = 0;
    if (!S.next(0, cur)) return;
    f32x4 acc[2][2][4][2];
#pragma unroll
    for (int a = 0; a < 2; ++a)
#pragma unroll
        for (int b = 0; b < 2; ++b)
#pragma unroll
            for (int m = 0; m < 4; ++m)
#pragma unroll
                for (int n = 0; n < 2; ++n) acc[a][b][m][n] = (f32x4){0.f, 0.f, 0.f, 0.f};
    bf16x8 At[4][2], B0[2][2], B1[2][2];
    const char* cA = (const char*)(cur.pn >= g.pn_split ? g.A2 : g.A) + (size_t)cur.pm * tstep; const char* cB = (const char*)g.Bt + (size_t)cur.pn * tstep;
    S.a_ready(cur);
    if constexpr (SP2) {
        PG8_STAGE(PG8_SB(0, 0), cB, voffB); PG8_STAGE(PG8_SB(0, 1), cB + hstep, voffB); PG8_STAGE(PG8_SA(0, 0), cA, voffA); PG8_STAGE(PG8_SA(0, 1), cA + hstep, voffA);
        if (wr == 1) PG8_BAR;
        PG8_WAIT_V(2); PG8_BAR;
        PG8_STAGE(PG8_SB(1, 0), cB + kstep, voffB); PG8_STAGE(PG8_SA(1, 0), cA + kstep, voffA); PG8_STAGE(PG8_SB(1, 1), cB + hstep + kstep, voffB);
        PG8_WAIT_V(6); PG8_BAR;
    } else {
        PG8_STAGE(PG8_SB(0, 0), cB, voffB); PG8_STAGE(PG8_SA(0, 0), cA, voffA); PG8_STAGE(PG8_SB(0, 1), cB + hstep, voffB); PG8_STAGE(PG8_SA(0, 1), cA + hstep, voffA);
        if (wr == 1) PG8_BAR;
        PG8_WAIT_V(4); PG8_BAR;
        PG8_STAGE(PG8_SB(1, 0), cB + kstep, voffB); PG8_STAGE(PG8_SA(1, 0), cA + kstep, voffA); PG8_STAGE(PG8_SB(1, 1), cB + hstep + kstep, voffB);
        PG8_WAIT_V(6); PG8_BAR;
    }
    for (;;) {
        const bool has_next = S.next(ui + 1, nxt);
        const char* nA = has_next ? (const char*)(nxt.pn >= g.pn_split ? g.A2 : g.A) + (size_t)nxt.pm * tstep : cA; const char* nB = has_next ? (const char*)g.Bt + (size_t)nxt.pn * tstep : cB;
        for (int t = 0; t < nt; t += 2) {
            const bool last = (t == nt - 2);
            const char* a1 = cA + (size_t)(t + 1) * kstep;
            const char* a2 = last ? nA : cA + (size_t)(t + 2) * kstep; const char* b2 = last ? nB : cB + (size_t)(t + 2) * kstep;
            const char* a3 = a2 + kstep; const char* b3 = b2 + kstep;
            if (last && has_next) S.a_ready(nxt);
            if constexpr (SP2) {
            PG8_LDB(B0, 0, 0); PG8_LDB(B1, 0, 1); PG8_SCHED; PG8_LDA(At, 0, 0); PG8_STAGE(PG8_SA(1, 1), a1 + hstep, voffA);
            PG8_WAIT_V(8); PG8_WAIT_L(0); PG8_BAR; PG8_MMA(0, 0, At, B0); PG8_MMA(0, 1, At, B1); PG8_BAR; PG8_SCHED;
            PG8_LDA(At, 0, 1); PG8_STAGE(PG8_SB(0, 0), b2, voffB); PG8_STAGE(PG8_SB(0, 1), b2 + hstep, voffB); PG8_STAGE(PG8_SA(0, 0), a2, voffA);
            PG8_WAIT_V(8); PG8_WAIT_L(0); PG8_BAR; PG8_MMA(1, 0, At, B0); PG8_MMA(1, 1, At, B1); PG8_BAR; PG8_SCHED;
            PG8_LDB(B0, 1, 0); PG8_LDB(B1, 1, 1); PG8_SCHED; PG8_LDA(At, 1, 0); PG8_STAGE(PG8_SA(0, 1), a2 + hstep, voffA);
            PG8_WAIT_V(8); PG8_WAIT_L(0); PG8_BAR; PG8_MMA(0, 0, At, B0); PG8_MMA(0, 1, At, B1); PG8_BAR; PG8_SCHED;
            PG8_LDA(At, 1, 1); PG8_STAGE(PG8_SB(1, 0), b3, voffB); PG8_STAGE(PG8_SB(1, 1), b3 + hstep, voffB); PG8_STAGE(PG8_SA(1, 0), a3, voffA);
            PG8_WAIT_V(8); PG8_WAIT_L(0); PG8_BAR; PG8_MMA(1, 0, At, B0); PG8_MMA(1, 1, At, B1); PG8_BAR; PG8_SCHED;
            } else {
            PG8_LDB(B0, 0, 0); PG8_SCHED; PG8_LDA(At, 0, 0); PG8_STAGE(PG8_SA(1, 1), a1 + hstep, voffA);
            PG8_WAIT_L(8); PG8_BAR; PG8_WAIT_L(0); PG8_MMA(0, 0, At, B0); PG8_BAR; PG8_SCHED;
            PG8_LDB(B1, 0, 1); PG8_STAGE(PG8_SB(0, 0), b2, voffB);
            PG8_BAR; PG8_WAIT_L(0); PG8_MMA(0, 1, At, B1); PG8_BAR;
            PG8_LDA(At, 0, 1); PG8_STAGE(PG8_SA(0, 0), a2, voffA);
            PG8_BAR; PG8_WAIT_L(0); PG8_MMA(1, 0, At, B0); PG8_BAR; PG8_SCHED;
            PG8_STAGE(PG8_SB(0, 1), b2 + hstep, voffB);
            PG8_WAIT_V(6); PG8_BAR; PG8_MMA(1, 1, At, B1); PG8_BAR;
            PG8_LDB(B0, 1, 0); PG8_SCHED; PG8_LDA(At, 1, 0); PG8_STAGE(PG8_SA(0, 1), a2 + hstep, voffA);
            PG8_WAIT_L(8); PG8_BAR; PG8_WAIT_L(0); PG8_MMA(0, 0, At, B0); PG8_BAR; PG8_SCHED;
            PG8_LDB(B1, 1, 1); PG8_STAGE(PG8_SB(1, 0), b3, voffB);
            PG8_BAR; PG8_WAIT_L(0); PG8_MMA(0, 1, At, B1); PG8_BAR;
            PG8_LDA(At, 1, 1); PG8_STAGE(PG8_SA(1, 0), a3, voffA);
            PG8_BAR; PG8_WAIT_L(0); PG8_MMA(1, 0, At, B0); PG8_BAR; PG8_SCHED;
            PG8_STAGE(PG8_SB(1, 1), b3 + hstep, voffB);
            PG8_WAIT_V(6); PG8_BAR; PG8_MMA(1, 1, At, B1); PG8_BAR;
            }
        }
        if constexpr (ALIGN_EPI) { if (wr == 0) PG8_BAR; }
        if constexpr (!Epi::AFTER_DRAIN) { E(acc, cur, wr, wc, fr, fq); S.done(cur); }
        if (!has_next) break;
#pragma unroll
        for (int a = 0; a < 2; ++a)
#pragma unroll
            for (int b = 0; b < 2; ++b)
#pragma unroll
                for (int m = 0; m < 4; ++m)
#pragma unroll
                    for (int n = 0; n < 2; ++n) acc[a][b][m][n] = (f32x4){0.f, 0.f, 0.f, 0.f};
        cur = nxt; cA = nA; cB = nB; ++ui;
        if constexpr (ALIGN_EPI) { if (wr == 1) PG8_BAR; }
    }
    PG8_WAIT_V(0);
    if constexpr (!ALIGN_EPI) { if (wr == 0) PG8_BAR; }
    PG8_BAR;
    if constexpr (Epi::AFTER_DRAIN) { E.fused(acc, cur, wr, wc, fr, fq, lds, wid, lane); S.done(cur); }
#undef PG8_SA
#undef PG8_SB
#undef PG8_STAGE
#undef PG8_LDA
#undef PG8_LDB
#undef PG8_MMA
#undef PG8_WAIT_V
#undef PG8_WAIT_L
#undef PG8_BAR
#undef PG8_SCHED
}
}
#include <hip/hip_bf16.h>
#include <cmath>
namespace attn_body {
using bf16=__hip_bfloat16;
using bf16x8=__attribute__((ext_vector_type(8)))short;
using s16x4=__attribute__((ext_vector_type(4)))short;
using f32x16=__attribute__((ext_vector_type(16)))float;
using u32x4=__attribute__((ext_vector_type(4)))unsigned;
constexpr int BATCH=4,SEQ=4096,D=64,DM=1024,OPITCH=2048;
constexpr int NW=8,QBLK=32,QB=QBLK*NW,KVBLK=64,NQB=SEQ/QB;
constexpr int ATTN_PITCH=DM, ATTN_UNIT_ROWS=QB;
__device__ __forceinline__ int crow(int r,int hi){return (r&3)+8*(r>>2)+4*hi;}
#define SBAR() __builtin_amdgcn_sched_barrier(0)
__device__ __forceinline__ void cmask(f32x16&p0,f32x16&p1,int jb,int qrel,int hi){
  const float NEG=-INFINITY; int kb=64*jb+4*hi;
  #pragma unroll
  for(int r=0;r<16;++r){int kv=kb+(r&3)+8*(r>>2); if(kv>qrel)p0[r]=NEG; if(kv+32>qrel)p1[r]=NEG;}
}

constexpr int NSLOT=3, SLOTB=8192;
constexpr int LDS_K=0, LDS_V=NSLOT*SLOTB, LDS_WS=2*NSLOT*SLOTB, LDS_OST=LDS_WS+NW*64*4, LDS_BYTES=LDS_OST+NW*4096;
constexpr float C2=0.125f*1.4426950408889634f;
__device__ __forceinline__ void glds16(const void*gsrc,unsigned lds_dst){unsigned keep;
  asm volatile("s_mov_b32 %0, m0\n\ts_mov_b32 m0, %2\n\ts_nop 0\n\tglobal_load_lds_dwordx4 %1, off\n\ts_mov_b32 m0, %0":"=&s"(keep):"v"(gsrc),"s"(lds_dst):"memory");}
__device__ __forceinline__ float max3f(float a,float b,float c){float r;asm("v_max3_f32 %0, %1, %2, %3":"=v"(r):"v"(a),"v"(b),"v"(c));return r;}
__device__ __forceinline__ float max2f(float a,float b){float r;asm("v_max_f32_e32 %0, %1, %2":"=v"(r):"v"(a),"v"(b));return r;}
__device__ __forceinline__ float fadd_s(float a,float b){float r;asm("v_add_f32_e32 %0, %1, %2":"=v"(r):"v"(a),"v"(b));return r;}
__device__ __forceinline__ float fsub_s(float a,float b){float r;asm("v_sub_f32_e32 %0, %1, %2":"=v"(r):"v"(a),"v"(b));return r;}
typedef float f32x2_t __attribute__((ext_vector_type(2))); typedef __bf16 bf16x2_t __attribute__((ext_vector_type(2)));
__device__ __forceinline__ unsigned cvtpk_s(float lo,float hi){f32x2_t v={lo,hi};bf16x2_t b=__builtin_convertvector(v,bf16x2_t);return __builtin_bit_cast(unsigned,b);}
#define WAIT_BAR(N) asm volatile("s_waitcnt vmcnt(" #N ") lgkmcnt(0)\n\ts_barrier":::"memory")

__device__ __forceinline__ void qkt(f32x16&p0,f32x16&p1,const char*Kslot,const bf16x8*qr,const f32x16&negm,int r32,int hi){
  const char*kb=Kslot+hi*1024+r32*16;
  #pragma unroll
  for(int d0=0;d0<4;++d0){
    const bf16x8 b0=*reinterpret_cast<const bf16x8*>(kb+d0*2048);
    const bf16x8 b1=*reinterpret_cast<const bf16x8*>(kb+d0*2048+512);
    if(d0==0){p0=__builtin_amdgcn_mfma_f32_32x32x16_bf16(b0,qr[0],negm,0,0,0);p1=__builtin_amdgcn_mfma_f32_32x32x16_bf16(b1,qr[0],negm,0,0,0);}
    else{p0=__builtin_amdgcn_mfma_f32_32x32x16_bf16(b0,qr[d0],p0,0,0,0);p1=__builtin_amdgcn_mfma_f32_32x32x16_bf16(b1,qr[d0],p1,0,0,0);}}
}
typedef __attribute__((address_space(3))) const char* lds_cptr;
typedef short v4i16_t __attribute__((ext_vector_type(4)));
__device__ __forceinline__ void kload8(bf16x8*kf,lds_cptr kp){
  kf[0]=*(const __attribute__((address_space(3))) bf16x8*)(kp);      kf[1]=*(const __attribute__((address_space(3))) bf16x8*)(kp+512);
  kf[2]=*(const __attribute__((address_space(3))) bf16x8*)(kp+2048); kf[3]=*(const __attribute__((address_space(3))) bf16x8*)(kp+2560);
  kf[4]=*(const __attribute__((address_space(3))) bf16x8*)(kp+4096); kf[5]=*(const __attribute__((address_space(3))) bf16x8*)(kp+4608);
  kf[6]=*(const __attribute__((address_space(3))) bf16x8*)(kp+6144); kf[7]=*(const __attribute__((address_space(3))) bf16x8*)(kp+6656);
}
__device__ __forceinline__ void kload2(bf16x8*kf,lds_cptr kp,int j){ kf[2*j]=*(const __attribute__((address_space(3))) bf16x8*)(kp+j*2048); kf[2*j+1]=*(const __attribute__((address_space(3))) bf16x8*)(kp+j*2048+512); }
__device__ __forceinline__ s16x4 vtr(lds_cptr p){ return __builtin_bit_cast(s16x4,__builtin_amdgcn_ds_read_tr16_b64_v4i16((__attribute__((address_space(3))) v4i16_t*)p)); }
__device__ __forceinline__ float rowmax(const f32x16&p0,const f32x16&p1){
  float a=max3f(p0[0],p0[1],p1[0]),b=max3f(p0[2],p0[3],p1[1]);a=max3f(a,p1[2],p1[3]);
  #pragma unroll
  for(int r=4;r<16;r+=4){a=max3f(a,p0[r],p0[r+1]);b=max3f(b,p0[r+2],p0[r+3]);a=max3f(a,p1[r],p1[r+1]);b=max3f(b,p1[r+2],p1[r+3]);}
  const float m=max2f(a,b);
  auto rr=__builtin_amdgcn_permlane32_swap(__float_as_uint(m),__float_as_uint(m),false,false);
  return max2f(__uint_as_float(rr[0]),__uint_as_float(rr[1]));
}
__device__ __forceinline__ void pv(f32x16*o,int vb,bf16x8 pa0,bf16x8 pa1,bf16x8 pa2,bf16x8 pa3){
  #pragma unroll
  for(int d0=0;d0<2;++d0){s16x4 lo[4],hi[4];
    #pragma unroll
    for(int ks=0;ks<4;++ks){
      asm volatile("ds_read_b64_tr_b16 %0,%1 offset:%c2":"=&v"(lo[ks]):"v"(vb),"i"(d0*4096+ks*1024):"memory");
      asm volatile("ds_read_b64_tr_b16 %0,%1 offset:%c2":"=&v"(hi[ks]):"v"(vb),"i"(d0*4096+ks*1024+512):"memory");}
    asm volatile("s_waitcnt lgkmcnt(0)":::"memory");SBAR();
    #define PK(k) (bf16x8){lo[k][0],lo[k][1],lo[k][2],lo[k][3],hi[k][0],hi[k][1],hi[k][2],hi[k][3]}
    o[d0]=__builtin_amdgcn_mfma_f32_32x32x16_bf16(pa0,PK(0),o[d0],0,0,0);
    o[d0]=__builtin_amdgcn_mfma_f32_32x32x16_bf16(pa1,PK(1),o[d0],0,0,0);
    o[d0]=__builtin_amdgcn_mfma_f32_32x32x16_bf16(pa2,PK(2),o[d0],0,0,0);
    o[d0]=__builtin_amdgcn_mfma_f32_32x32x16_bf16(pa3,PK(3),o[d0],0,0,0);
    #undef PK
  }
}

#ifndef ATTN_STORE16
#define ATTN_STORE16(p,v) (*(u32x4*)(p)=(v))
#endif
template<int THRL> __device__ __forceinline__ void attn_unit(int b,int qcol,int vcol,int ocol,int qb,const bf16*Q,const bf16*__restrict__ K,const bf16*__restrict__ V,bf16*O,char*shm){
  int tid=threadIdx.x; asm volatile("":"+v"(tid));
  const int lane=tid&63,r32=lane&31,hi=lane>>5; const int wid=__builtin_amdgcn_readfirstlane(tid>>6);
  const long rowbase=(long)b*SEQ; const int q0=qb*QB;
  const bf16*Qw=Q+(rowbase+q0+wid*QBLK)*DM+qcol;
  const bf16*Kh=K+rowbase*DM+qcol,*Vh=V+rowbase*DM+vcol;
  const unsigned lds0=(unsigned)(uintptr_t)shm;
  float*wsf=(float*)(shm+LDS_WS)+wid*64;
  const bf16*ksrc=Kh+(long)lane*DM+wid*8;
  const bf16*vsrc=Vh+(long)(16*(wid&3)+(lane>>2))*DM+(wid>>2)*32+(lane&3)*8;
  const unsigned kdst=lds0+LDS_K+wid*1024, vdst=lds0+LDS_V+wid*1024;
  #define DMA_K(t,slot) glds16(ksrc+(long)(t)*KVBLK*DM,(unsigned)__builtin_amdgcn_readfirstlane(kdst+(slot)))
  #define DMA_V(t,slot) glds16(vsrc+(long)(t)*KVBLK*DM,(unsigned)__builtin_amdgcn_readfirstlane(vdst+(slot)))
  const int vb0=(int)(lds0+LDS_V)+((lane>>4)&1)*32+(lane&3)*8+(4*hi+((lane&15)>>2))*64;
  const char*Kbase=shm+LDS_K; bf16x8 kf[8];
  const lds_cptr shm3=(lds_cptr)shm; const lds_cptr kp0=shm3+LDS_K+hi*1024+r32*16; const lds_cptr vp0=shm3+LDS_V+((lane>>4)&1)*32+(lane&3)*8+(4*hi+((lane&15)>>2))*64;
  const int NT=(q0+QB)/KVBLK;
  DMA_K(0,0);DMA_V(0,0);DMA_K(1,SLOTB);
  bf16x8 qr[4];
  #pragma unroll
  for(int d0=0;d0<4;++d0)qr[d0]=*reinterpret_cast<const bf16x8*>(&Qw[(long)r32*DM+d0*16+hi*8]);
  float mhat=0.f,l_reg=0.f;f32x16 o[2];o[0]=f32x16{};o[1]=f32x16{};asm volatile("":"+v"(o[0]),"+v"(o[1]));f32x16 negm=f32x16{};asm volatile("":"+v"(negm));
  const int qrel=wid*QBLK+r32;
  #define CMASK(P0,P1,t) do{int jb_=(t)-(NT-4); if(jb_>=0)cmask(P0,P1,jb_,qrel,hi);}while(0)
  bool resc=false;
  #define START(P0,P1) do{ const float rm=rowmax(P0,P1); resc=false; \
    { const float dl=rm; mhat=fadd_s(mhat,dl); \
      _Pragma("unroll") for(int r=0;r<16;++r){P0[r]=fsub_s(P0[r],dl);P1[r]=fsub_s(P1[r],dl);} \
      _Pragma("unroll") for(int r=0;r<16;++r)negm[r]=-mhat; asm volatile("":"+v"(negm)); } \
    _Pragma("unroll") for(int r=0;r<16;++r)P0[r]=__builtin_amdgcn_exp2f(P0[r]); }while(0)
  #define RESC() do{ if(resc){ asm volatile("s_waitcnt lgkmcnt(0)":::"memory"); \
      _Pragma("unroll") for(int d_=0;d_<2;++d_) _Pragma("unroll") for(int r=0;r<16;++r)o[d_][r]*=wsf[crow(r,hi)]; } }while(0)
  f32x16 pA0,pA1,pB0,pB1;
  int sl_prev=0,sl_cur=0,sl_next=SLOTB;
  #define ROT() do{sl_prev=sl_cur;sl_cur=sl_next;sl_next=(sl_next==(NSLOT-1)*SLOTB)?0:sl_next+SLOTB;}while(0)
  DMA_K(2,2*SLOTB);
  WAIT_BAR(3);
  qkt(pA0,pA1,Kbase,qr,negm,r32,hi);asm volatile("s_nop 15\n\ts_nop 7":"+v"(pA0),"+v"(pA1));CMASK(pA0,pA1,0);
  START(pA0,pA1);
  _Pragma("unroll") for(int r=0;r<16;++r)pA1[r]=__builtin_amdgcn_exp2f(pA1[r]);
  WAIT_BAR(0);
  DMA_K(3,0);DMA_V(1,SLOTB);
  ROT();
  kload8(kf,kp0+sl_cur);
  WAIT_BAR(2);
  s16x4 vlo[8],vhi[8]; u32x4 pw0,pw1,pw2,pw3;
  #define PKW(P,B) cvtpk_s(P[B],P[B+1])
  #define PAF(k) __builtin_bit_cast(bf16x8,pw##k)
  #define VFR(i) (bf16x8){vlo[i][0],vlo[i][1],vlo[i][2],vlo[i][3],vhi[i][0],vhi[i][1],vhi[i][2],vhi[i][3]}
  #define PIN(x) asm volatile("":"+v"(x))
  #define MX3(a,b,c) __builtin_fmaxf(__builtin_fmaxf((a),(b)),(c))
  #define GAPA(MF,A0,A1,A2,A3,W0,W1,PW) do{ MF; sacc+=A0; sacc+=A1; sacc+=A2; sacc+=A3; PIN(sacc); W0; W1; PIN(PW); SBAR(); }while(0)
  #define EX(v) __builtin_amdgcn_exp2f(v)
  #define GAPB(MF,X,B) do{ MF; X[B]=EX(X[B]); X[B+1]=EX(X[B+1]); X[B+2]=EX(X[B+2]); X[B+3]=EX(X[B+3]); PIN(X); SBAR(); }while(0)
  #define VRD(i) do{ vlo[i]=vtr(vp_+(((i)>>2)*4096+((i)&3)*1024)); vhi[i]=vtr(vp_+(((i)>>2)*4096+((i)&3)*1024+512)); }while(0)
  #define KRD(G,j) do{ if(G){ kload2(kf,kp0+sl_next,j); SBAR(); } }while(0)
  #define STEP(C0,C1,P0,P1,t,GK,GV,GL) do{ SBAR(); \
    const lds_cptr vp_=vp0+sl_prev; \
    VRD(0); SBAR(); float sacc=(P0[0]+P0[1]); \
    GAPA(C0=__builtin_amdgcn_mfma_f32_32x32x16_bf16(kf[0],qr[0],negm,0,0,0), P0[2],P0[3],P0[4],P0[5],     pw0[0]=PKW(P0,0), pw0[1]=PKW(P0,2), pw0); \
    VRD(4); SBAR(); GAPA(C1=__builtin_amdgcn_mfma_f32_32x32x16_bf16(kf[1],qr[0],negm,0,0,0), P0[6],P0[7],P0[8],P0[9],     pw0[2]=PKW(P0,4), pw0[3]=PKW(P0,6), pw0); \
    VRD(1); SBAR(); GAPA(C0=__builtin_amdgcn_mfma_f32_32x32x16_bf16(kf[2],qr[1],C0,0,0,0),   P0[10],P0[11],P0[12],P0[13], pw1[0]=PKW(P0,8), pw1[1]=PKW(P0,10), pw1); \
    VRD(5); SBAR(); GAPA(C1=__builtin_amdgcn_mfma_f32_32x32x16_bf16(kf[3],qr[1],C1,0,0,0),   P0[14],P0[15],P1[0],P1[1],   pw1[2]=PKW(P0,12),pw1[3]=PKW(P0,14), pw1); \
    VRD(2); SBAR(); GAPA(C0=__builtin_amdgcn_mfma_f32_32x32x16_bf16(kf[4],qr[2],C0,0,0,0),   P1[2],P1[3],P1[4],P1[5],     pw2[0]=PKW(P1,0), pw2[1]=PKW(P1,2), pw2); \
    VRD(6); SBAR(); GAPA(C1=__builtin_amdgcn_mfma_f32_32x32x16_bf16(kf[5],qr[2],C1,0,0,0),   P1[6],P1[7],P1[8],P1[9],     pw2[2]=PKW(P1,4), pw2[3]=PKW(P1,6), pw2); \
    VRD(3); SBAR(); GAPA(C0=__builtin_amdgcn_mfma_f32_32x32x16_bf16(kf[6],qr[3],C0,0,0,0),   P1[10],P1[11],P1[12],P1[13], pw3[0]=PKW(P1,8), pw3[1]=PKW(P1,10), pw3); \
    VRD(7); SBAR(); GAPA(C1=__builtin_amdgcn_mfma_f32_32x32x16_bf16(kf[7],qr[3],C1,0,0,0),   P1[14],P1[15],0.f,0.f,       pw3[2]=PKW(P1,12),pw3[3]=PKW(P1,14), pw3); \
    l_reg+=sacc; \
    if(GK){DMA_K((t)+3,sl_cur);} if(GV){DMA_V((t)+1,sl_next);} \
    CMASK(C0,C1,t); \
    { float a=MX3(C0[0],C0[1],C1[0]),b=MX3(C0[2],C0[3],C1[1]); a=MX3(a,C1[2],C1[3]); \
      _Pragma("unroll") for(int r=4;r<16;r+=4){a=MX3(a,C0[r],C0[r+1]);b=MX3(b,C0[r+2],C0[r+3]);a=MX3(a,C1[r],C1[r+1]);b=MX3(b,C1[r+2],C1[r+3]);} \
      float rm=__builtin_fmaxf(a,b); { auto rr=__builtin_amdgcn_permlane32_swap(__float_as_uint(rm),__float_as_uint(rm),false,false); rm=__builtin_fmaxf(__uint_as_float(rr[0]),__uint_as_float(rr[1])); } \
      resc=false; \
      if(__builtin_expect(__any(rm>(float)THRL),0)){ const float dl=__builtin_fmaxf(rm,0.f); mhat+=dl; \
        _Pragma("unroll") for(int r=0;r<16;++r){C0[r]-=dl;C1[r]-=dl;} \
        _Pragma("unroll") for(int r=0;r<16;++r)negm[r]=-mhat; asm volatile("":"+v"(negm)); \
        const float f=__builtin_amdgcn_exp2f(-dl); l_reg*=f; if(hi==0)wsf[r32]=f; resc=true; } } \
    SBAR(); \
    GAPB(o[0]=__builtin_amdgcn_mfma_f32_32x32x16_bf16(PAF(0),VFR(0),o[0],0,0,0), C0,0); \
    GAPB(o[1]=__builtin_amdgcn_mfma_f32_32x32x16_bf16(PAF(0),VFR(4),o[1],0,0,0), C0,4); \
    KRD(GL,0); GAPB(o[0]=__builtin_amdgcn_mfma_f32_32x32x16_bf16(PAF(1),VFR(1),o[0],0,0,0), C0,8); \
    KRD(GL,1); GAPB(o[1]=__builtin_amdgcn_mfma_f32_32x32x16_bf16(PAF(1),VFR(5),o[1],0,0,0), C0,12); \
    KRD(GL,2); GAPB(o[0]=__builtin_amdgcn_mfma_f32_32x32x16_bf16(PAF(2),VFR(2),o[0],0,0,0), C1,0); \
    KRD(GL,3); GAPB(o[1]=__builtin_amdgcn_mfma_f32_32x32x16_bf16(PAF(2),VFR(6),o[1],0,0,0), C1,4); \
    GAPB(o[0]=__builtin_amdgcn_mfma_f32_32x32x16_bf16(PAF(3),VFR(3),o[0],0,0,0), C1,8); \
    GAPB(o[1]=__builtin_amdgcn_mfma_f32_32x32x16_bf16(PAF(3),VFR(7),o[1],0,0,0), C1,12); \
    }while(0)
  int t=1;
  #undef CMASK
  #define CMASK(P0,P1,t) do{}while(0)
  for(;t+5<NT;t+=2){
    STEP(pB0,pB1,pA0,pA1,t,true,true,true);     WAIT_BAR(2); RESC(); ROT();
    STEP(pA0,pA1,pB0,pB1,t+1,true,true,true);   WAIT_BAR(2); RESC(); ROT();
  }
  #undef CMASK
  #define CMASK(P0,P1,t) do{int jb_=(t)-(NT-4); if(jb_>=0)cmask(P0,P1,jb_,qrel,hi);}while(0)
  #define ENDW(tt) do{ if((tt)+3<NT){WAIT_BAR(2);} else if((tt)+2<NT){WAIT_BAR(1);} else {WAIT_BAR(0);} }while(0)
  for(;t+1<NT;t+=2){
    STEP(pB0,pB1,pA0,pA1,t,(t+3<NT),(t+1<NT),(t+1<NT));       ENDW(t);   RESC(); ROT();
    STEP(pA0,pA1,pB0,pB1,t+1,(t+4<NT),(t+2<NT),(t+2<NT));     ENDW(t+1); RESC(); ROT();
  }
  STEP(pB0,pB1,pA0,pA1,NT-1,false,false,false); RESC();
  { float sacc=pB0[0]+pB0[1]; _Pragma("unroll") for(int r=2;r<16;++r)sacc+=pB0[r]; _Pragma("unroll") for(int r=0;r<16;++r)sacc+=pB1[r]; l_reg+=sacc;
    pw0=(u32x4){PKW(pB0,0),PKW(pB0,2),PKW(pB0,4),PKW(pB0,6)};pw1=(u32x4){PKW(pB0,8),PKW(pB0,10),PKW(pB0,12),PKW(pB0,14)};pw2=(u32x4){PKW(pB1,0),PKW(pB1,2),PKW(pB1,4),PKW(pB1,6)};pw3=(u32x4){PKW(pB1,8),PKW(pB1,10),PKW(pB1,12),PKW(pB1,14)};
    SBAR(); pv(o,vb0+sl_cur,PAF(0),PAF(1),PAF(2),PAF(3)); }
  #undef PKW
  #undef PAF
  #undef VFR
  #undef PIN
  #undef MX3
  #undef GAPA
  #undef GAPB
  #undef EX
  #undef VRD
  #undef KRD
  #undef STEP
  #undef ENDW
  {auto rr=__builtin_amdgcn_permlane32_swap(__float_as_uint(l_reg),__float_as_uint(l_reg),false,false);l_reg=__uint_as_float(rr[0])+__uint_as_float(rr[1]);}
  if(hi==0)wsf[32+r32]=l_reg;asm volatile("s_waitcnt lgkmcnt(0)":::"memory");
  float rli[16];
  #pragma unroll
  for(int r=0;r<16;++r)rli[r]=__builtin_amdgcn_rcpf(wsf[32+crow(r,hi)]);
  bf16*Ow=O+(rowbase+q0+wid*QBLK)*OPITCH+ocol;
  { bf16*stg=(bf16*)(shm+LDS_OST)+wid*2048;
    #pragma unroll
    for(int r=0;r<16;++r){const int orow=crow(r,hi);
      #pragma unroll
      for(int d0=0;d0<2;++d0)stg[orow*64+d0*32+r32]=__float2bfloat16(o[d0][r]*rli[r]);}
    asm volatile("s_waitcnt lgkmcnt(0)":::"memory");
    int lane2=lane; asm volatile("":"+v"(lane2));
    #pragma unroll
    for(int i=0;i<4;++i){const int row=i*8+(lane2>>3),ch=lane2&7; const u32x4 v=*(const u32x4*)(stg+row*64+ch*8); ATTN_STORE16(Ow+(long)row*OPITCH+ch*8,v);} }
  asm volatile("s_waitcnt lgkmcnt(0)\n\ts_barrier":::"memory");
  #undef DMA_K
  #undef DMA_V
  #undef CMASK
  #undef START
  #undef RESC
  #undef ROT
}
constexpr int ATTN_LDS_BYTES=LDS_BYTES;
#undef SBAR
#undef WAIT_BAR
}

#define LAS __attribute__((address_space(3)))
typedef unsigned short bf16;
typedef unsigned v4u __attribute__((ext_vector_type(4)));
typedef float f32x4 __attribute__((ext_vector_type(4)));
typedef short bf16x8 __attribute__((ext_vector_type(8)));
#define LDS_WAIT() asm volatile("s_waitcnt lgkmcnt(0)" ::: "memory")
#define VM_WAIT() asm volatile("s_waitcnt vmcnt(0)" ::: "memory")

constexpr int NWAVES = 8, NTHR = 512, GRID = 256;
constexpr int BATCH = 4, SEQ = 4096, T = BATCH * SEQ, DM = 1024, NH = 8, FF = 4096, DIN = 8208;
constexpr int NCHUNK = SEQ / 64, NITEM = BATCH * NH * NCHUNK;
constexpr float EPS = 1e-6f;
constexpr float QSCALE = 0.125f * 1.4426950408889634f;
constexpr int NPHASE = 13;
#ifndef PH_MASK
#define PH_MASK 0x1fff
#endif
#ifndef MK_PER_PHASE
#define MK_PER_PHASE 0
#endif

constexpr size_t MiB = 1u << 20;
constexpr size_t WS_ROPE = 1 * MiB, WS_IFG = 2 * MiB, WS_SS1 = 3 * MiB, WS_SS2 = 3 * MiB + 256 * 1024, WS_CHK = 3 * MiB + 512 * 1024, WS_LAM = 3 * MiB + 768 * 1024;
constexpr size_t WS_NST = 4 * MiB, WS_WTIF = 5 * MiB;
constexpr size_t WS_WTIN = 6 * MiB, WS_WTAB = 22 * MiB, WS_WTOUT = 26 * MiB, WS_WTFF1 = 30 * MiB, WS_WTFF2 = 38 * MiB;
constexpr size_t WS_XN = 46 * MiB, WS_QA = 78 * MiB, WS_KA = 110 * MiB, WS_VA = 142 * MiB, WS_QKM = 174 * MiB, WS_VM = 206 * MiB, WS_END = 238 * MiB;
constexpr size_t WS_UST = WS_KA;
constexpr size_t WS_Y = WS_KA;
constexpr size_t WS_HB = WS_QKM;
constexpr size_t WS_U = WS_XN;

struct Params {
    const float* x; const int* pos; const float* norm_mix_w; const float* w_in; const float* gate_b; const float* conv_w; const float* conv_b; const float* da_lambda;
    const float* subln_w; const float* ml_norm_w; const float* w_a; const float* w_b; const float* w_out; const float* norm_ffn_w; const float* w_ff1; const float* w_ff2; const float* final_w;
    float* out; unsigned char* ws; int ph_lo, ph_hi;
};

__device__ __forceinline__ float bf_lo_(unsigned w) { return __uint_as_float(w << 16); }
__device__ __forceinline__ float bf_hi_(unsigned w) { return __uint_as_float(w & 0xffff0000u); }
__device__ __forceinline__ float bf2f(bf16 v) { return __uint_as_float((unsigned)v << 16); }
__device__ __forceinline__ unsigned f2bf(float f) { unsigned u = __builtin_bit_cast(unsigned, f); return (u + 0x7fffu + ((u >> 16) & 1u)) >> 16; }
__device__ __forceinline__ unsigned pk2(float lo, float hi) { return f2bf(lo) | (f2bf(hi) << 16); }
__device__ __forceinline__ float sigm_(float x) { return 1.f / (1.f + __expf(-x)); }
__device__ __forceinline__ float wave_sum(float v) {
#pragma unroll
    for (int o = 1; o < 64; o <<= 1) v += __shfl_xor(v, o);
    return v;
}
__device__ __forceinline__ float wave_max(float v) {
#pragma unroll
    for (int o = 1; o < 64; o <<= 1) v = fmaxf(v, __shfl_xor(v, o));
    return v;
}

#define GAS __attribute__((address_space(1)))
typedef GAS unsigned gu32;
#define RLX_AGENT __ATOMIC_RELAXED, __HIP_MEMORY_SCOPE_AGENT
constexpr int CW_BAR = 4096;
#define XB_TMO      128
#define XB_XCNT(j)  (256  + 64 * (j))
#define XB_XSUB(j)  (1280 + 64 * (j))
#define XB_XGEN(j)  (2304 + 64 * (j))
#define XB_TOP      3328
#define XB_TOPGEN   3392
#define XCD_BAR_WORDS 3456
#define XB_SPIN_CAP (1u << 18)

__device__ __forceinline__ unsigned xb_ld(unsigned* p)              { return __hip_atomic_load(p, __ATOMIC_RELAXED, __HIP_MEMORY_SCOPE_AGENT); }
__device__ __forceinline__ unsigned xb_add(unsigned* p, unsigned v) { return __hip_atomic_fetch_add(p, v, __ATOMIC_RELAXED, __HIP_MEMORY_SCOPE_AGENT); }
__device__ __forceinline__ unsigned xb_xcc_id() { return (unsigned)__builtin_amdgcn_s_getreg((3 << 11) | 20) & 0xFu; }
#define XB_SPIN(cond, bar) do { unsigned _sp = 0; while (cond) { __builtin_amdgcn_s_sleep(1); \
    if ((++_sp & 255u) == 0u) { if (xb_ld(&(bar)[XB_TMO])) break; if (_sp > XB_SPIN_CAP) { atomicAdd(&(bar)[XB_TMO], 1u); break; } } } } while (0)

struct XcdBarrier {
    unsigned* bar; unsigned x;
    volatile LAS unsigned* st;
};

__device__ __forceinline__ XcdBarrier xcd_barrier_post(unsigned* bar, volatile LAS unsigned* st) {
    XcdBarrier b; b.bar = bar; b.x = xb_xcc_id(); b.st = st;
    if (threadIdx.x == 0) (void)xb_add(&bar[XB_XCNT(b.x)], 1u);
    return b;
}
__device__ __forceinline__ void xcd_barrier_complete(unsigned* bar, unsigned x, unsigned& nloc, unsigned& nx) {
    const unsigned G = gridDim.x * gridDim.y * gridDim.z;
    unsigned sum, cnt, mine, sp = 0u;
    for (;;) {
        sum = 0u; cnt = 0u; mine = 0u;
#pragma unroll
        for (unsigned j = 0; j < 16; ++j) { const unsigned c = xb_ld(&bar[XB_XCNT(j)]); sum += c; cnt += (c > 0u) ? 1u : 0u; mine = (j == x) ? c : mine; }
        if (sum == G) break;
        __builtin_amdgcn_s_sleep(1);
        if ((++sp & 255u) == 0u) { if (xb_ld(&bar[XB_TMO])) break; if (sp > XB_SPIN_CAP) { atomicAdd(&bar[XB_TMO], 1u); break; } }
    }
    nloc = mine > 0u ? mine : 1u; nx = cnt > 0u ? cnt : 1u;
}

__device__ __forceinline__ void xcd_barrier(const XcdBarrier& b) {
    asm volatile("s_waitcnt vmcnt(0)" ::: "memory");
    __syncthreads();
    if (threadIdx.x == 0) {
        unsigned* bar = b.bar;
        __builtin_amdgcn_s_waitcnt(0);
        unsigned nloc = b.st[0], nx = b.st[1];
        if (nloc == 0u) { xcd_barrier_complete(bar, b.x, nloc, nx); b.st[0] = nloc; b.st[1] = nx; }
        const unsigned old = xb_add(&bar[XB_XSUB(b.x)], 1u);
        const unsigned gen = old / nloc;
        if (old + 1u == (gen + 1u) * nloc) {
            __builtin_amdgcn_fence(__ATOMIC_RELEASE, "agent");
            asm volatile("s_waitcnt vmcnt(0)" ::: "memory");
            const unsigned og = xb_add(&bar[XB_TOP], 1u);
            const unsigned tg = og / nx;
            if (og + 1u == (tg + 1u) * nx) xb_add(&bar[XB_TOPGEN], 1u);
            else XB_SPIN(xb_ld(&bar[XB_TOPGEN]) == tg, bar);
            __builtin_amdgcn_fence(__ATOMIC_ACQUIRE, "agent");
            xb_add(&bar[XB_XGEN(b.x)], 1u);
            asm volatile("s_waitcnt vmcnt(0)" ::: "memory");
        } else {
            XB_SPIN(xb_ld(&bar[XB_XGEN(b.x)]) == gen, bar);
            __builtin_amdgcn_fence(__ATOMIC_ACQUIRE, "agent");
            asm volatile("s_waitcnt vmcnt(0)" ::: "memory");
        }
    }
    __syncthreads();
}


__device__ __forceinline__ void p0_transpose_item(const float* W, int ldw, int k0, int n_src0, int nvalid, bf16* WT, int dst_row0, int ldt, int kdst_off,
                                                  const float* ks, int ksmask, float kmul, LAS float* scr, int lane) {
#pragma unroll 8
    for (int i = 0; i < 32; ++i) { const int kk = 2 * i + (lane >> 5), n = lane & 31;
        float v = (n < nvalid) ? W[(size_t)(k0 + kk) * ldw + n_src0 + n] : 0.f;
        if (ks) v *= ks[(k0 + kk) & ksmask] * kmul;
        scr[kk * 33 + n] = v; }
    LDS_WAIT(); asm volatile("" ::: "memory");
    const int c = lane & 7;
#pragma unroll
    for (int j = 0; j < 4; ++j) { const int n = (lane >> 3) + 8 * j; const LAS float* s = scr + (8 * c) * 33 + n;
        v4u o; o.x = pk2(s[0 * 33], s[1 * 33]); o.y = pk2(s[2 * 33], s[3 * 33]); o.z = pk2(s[4 * 33], s[5 * 33]); o.w = pk2(s[6 * 33], s[7 * 33]);
        if (n < nvalid) *(v4u*)(WT + (size_t)(dst_row0 + n) * ldt + kdst_off + k0 + 8 * c) = o; }
    LDS_WAIT(); asm volatile("" ::: "memory");
}
__device__ __forceinline__ void p0_prologue(const Params& p, LAS unsigned char* lds, int vcu) {
    int tid_ = threadIdx.x; asm volatile("" : "+v"(tid_)); const int lane = tid_ & 63, wave = __builtin_amdgcn_readfirstlane(tid_ >> 6);
    unsigned char* ws = p.ws;
    LAS float* scr = (LAS float*)(lds + wave * 16384);
    const int gw = vcu * NWAVES + wave, NGW = GRID * NWAVES;
    bf16* WTIN = (bf16*)(ws + WS_WTIN); bf16* WTIF = (bf16*)(ws + WS_WTIF); bf16* WTAB = (bf16*)(ws + WS_WTAB); bf16* WTOUT = (bf16*)(ws + WS_WTOUT);
    bf16* WTFF1 = (bf16*)(ws + WS_WTFF1); bf16* WTFF2 = (bf16*)(ws + WS_WTFF2);
    constexpr int I_IN = 16 * 256, I_IF = 16, I_A = 16 * 32, I_B = 16 * 32, I_O = 16 * 32 * 2, I_1 = 16 * 128, I_2 = 64 * 32;
    constexpr int NITEMS = I_IN + I_IF + I_A + I_B + I_O + I_1 + I_2;
    for (int it = gw; it < NITEMS; it += NGW) {
        int r = it;
        if (r < I_IN) { const int kb = r / 256, nb = r % 256, n0 = nb * 32; const int src = n0 + (n0 >= 5120 ? 16 : 0);
            p0_transpose_item(p.w_in, DIN, kb * 64, src, 32, WTIN, n0, 1024, 0, nullptr, 0, 1.f, scr, lane); continue; } r -= I_IN;
        if (r < I_IF) { p0_transpose_item(p.w_in, DIN, r * 64, 5120, 16, WTIF, 0, 1024, 0, nullptr, 0, 1.f, scr, lane); continue; } r -= I_IF;
        if (r < I_A) { const int kb = r / 32, nb = r % 32; p0_transpose_item(p.w_a, 1024, kb * 64, nb * 32, 32, WTAB, nb * 32, 1024, 0, p.subln_w, 127, 0.8f, scr, lane); continue; } r -= I_A;
        if (r < I_B) { const int kb = r / 32, nb = r % 32; p0_transpose_item(p.w_b, 1024, kb * 64, nb * 32, 32, WTAB, 1024 + nb * 32, 1024, 0, p.ml_norm_w, 1023, 1.f, scr, lane); continue; } r -= I_B;
        if (r < I_O) { const int half = r / 512, q = r % 512, kb = q / 32, nb = q % 32; p0_transpose_item(p.w_out, 1024, kb * 64, nb * 32, 32, WTOUT, nb * 32, 2048, half * 1024, nullptr, 0, 1.f, scr, lane); continue; } r -= I_O;
        if (r < I_1) { const int kb = r / 128, nb = r % 128; p0_transpose_item(p.w_ff1, FF, kb * 64, nb * 32, 32, WTFF1, nb * 32, 1024, 0, p.norm_ffn_w, 1023, 1.f, scr, lane); continue; } r -= I_1;
        { const int kb = r / 32, nb = r % 32; p0_transpose_item(p.w_ff2, 1024, kb * 64, nb * 32, 32, WTFF2, nb * 32, FF, 0, nullptr, 0, 1.f, scr, lane); }
    }
    bf16* XN = (bf16*)(ws + WS_XN);
    for (int m = gw; m < T; m += NGW) {
        const f32x4* xr = (const f32x4*)(p.x + (size_t)m * DM) + lane; const f32x4* wr_ = (const f32x4*)p.norm_mix_w + lane;
        f32x4 v[4]; float s = 0.f;
#pragma unroll
        for (int j = 0; j < 4; ++j) { v[j] = xr[64 * j]; s += (v[j].x * v[j].x + v[j].y * v[j].y) + (v[j].z * v[j].z + v[j].w * v[j].w); }
        const float rstd = 1.f / sqrtf(wave_sum(s) * (1.f / DM) + EPS);
        unsigned long long* o8 = (unsigned long long*)(XN + (size_t)m * DM) + lane;
#pragma unroll
        for (int j = 0; j < 4; ++j) { const f32x4 w = wr_[64 * j]; o8[64 * j] = (unsigned long long)pk2(v[j].x * rstd * w.x, v[j].y * rstd * w.y) | ((unsigned long long)pk2(v[j].z * rstd * w.z, v[j].w * rstd * w.w) << 32); }
    }
    { const int g = blockIdx.x * NTHR + tid_;
        float* rope = (float*)(ws + WS_ROPE);
        for (int e = g; e < T * 8; e += GRID * NTHR) { const int t = e >> 3, i = e & 7;
            const float inv = (float)exp(-(double)i * (1.0 / 8.0) * 13.122363377404328);
            const float ang = (float)p.pos[t] * inv;
            double rev = (double)ang * 0.15915494309189535; rev -= floor(rev);
            const float rv = (float)rev;
            rope[t * 16 + i] = __builtin_amdgcn_cosf(rv); rope[t * 16 + 8 + i] = __builtin_amdgcn_sinf(rv); } }
    if (blockIdx.x == 0 && wave == 0) { const float* L = p.da_lambda; const float a = wave_sum(L[lane] * L[64 + lane]), b = wave_sum(L[128 + lane] * L[192 + lane]);
        if (lane == 0) *(float*)(ws + WS_LAM) = expf(a) - expf(b) + 0.2f; }
}

__device__ __forceinline__ void p1_gates(const Params& p, int vcu) {
    int tid_ = threadIdx.x; asm volatile("" : "+v"(tid_)); const int lane = tid_ & 63, wave = __builtin_amdgcn_readfirstlane(tid_ >> 6);
    const bf16* XN = (const bf16*)(p.ws + WS_XN); const bf16* WTIF = (const bf16*)(p.ws + WS_WTIF); float* IFG = (float*)(p.ws + WS_IFG);
    const int gw = vcu * NWAVES + wave, NGW = GRID * NWAVES;
    for (int it = gw; it < T / 16; it += NGW) {
        const bf16* ap = XN + (size_t)(it * 16 + (lane & 15)) * DM + (lane >> 4) * 8; const bf16* bp = WTIF + (size_t)(lane & 15) * DM + (lane >> 4) * 8;
        f32x4 acc = {0.f, 0.f, 0.f, 0.f};
#pragma unroll 8
        for (int kk = 0; kk < 32; ++kk) { const bf16x8 a = *(const bf16x8*)(ap + kk * 32), b = *(const bf16x8*)(bp + kk * 32); acc = __builtin_amdgcn_mfma_f32_16x16x32_bf16(a, b, acc, 0, 0, 0); }
        const int n = lane & 15; const float gb = p.gate_b[n];
#pragma unroll
        for (int r = 0; r < 4; ++r) { const int tok = it * 16 + (lane >> 4) * 4 + r; float v = acc[r] + gb;
            if (n >= 8) v = fminf(v, 0.f) - log1pf(__expf(-fabsf(v)));
            IFG[(size_t)tok * 16 + n] = v; }
    }
}

__device__ __forceinline__ void attn_phase(const Params& p, char* lds, int vcu) {
    using abf = attn_body::bf16;
    {
        const abf* QA = (const abf*)(p.ws + WS_QA); const abf* KA = (const abf*)(p.ws + WS_KA); const abf* VA = (const abf*)(p.ws + WS_VA); abf* OATT = (abf*)p.out;
        const int bh = vcu >> 3, s = vcu & 7, b = bh >> 3, h = bh & 7;
#pragma unroll 1
        for (int su = 0; su < 8; ++su) {
            const int qb = (su < 4) ? 15 - s : s, c = (su >> 1) & 1, hf = su & 1;
            attn_body::attn_unit<8>(b, h * 128 + c * 64, h * 128 + hf * 64, h * 256 + c * 128 + hf * 64, qb, QA, KA, VA, OATT, lds);
        }
    }
    VM_WAIT(); __syncthreads();
    {
        int tid = threadIdx.x; asm volatile("" : "+v"(tid));
        const int bh = vcu >> 3, s = vcu & 7, b = bh >> 3, h = bh & 7;
        const float lam = *(const float*)(p.ws + WS_LAM);
        const bf16* O = (const bf16*)p.out; bf16* OAN = (bf16*)(p.ws + WS_QA);
#pragma unroll 1
        for (int ps = 0; ps < 8; ++ps) {
            const int qb = (ps < 4) ? 15 - s : s;
            const int r = (ps & 3) * 64 + (tid >> 3), v0 = (tid & 7) * 16; const size_t t = (size_t)b * SEQ + qb * 256 + r;
            const v4u* o0 = (const v4u*)(O + t * 2048 + h * 256 + v0); const v4u* o1 = (const v4u*)(O + t * 2048 + h * 256 + 128 + v0);
            float d[16]; float ss = 0.f;
#pragma unroll
            for (int j = 0; j < 2; ++j) { const v4u a = o0[j], bb = o1[j];
#pragma unroll
                for (int e = 0; e < 4; ++e) { const float lo = bf_lo_(a[e]) - lam * bf_lo_(bb[e]), hi = bf_hi_(a[e]) - lam * bf_hi_(bb[e]); d[j * 8 + 2 * e] = lo; d[j * 8 + 2 * e + 1] = hi; ss += lo * lo + hi * hi; } }
            ss += __shfl_xor(ss, 1); ss += __shfl_xor(ss, 2); ss += __shfl_xor(ss, 4);
            const float rstd = 1.f / sqrtf(ss * (1.f / 128.f) + EPS);
            v4u w0, w1;
#pragma unroll
            for (int e = 0; e < 4; ++e) { w0[e] = pk2(d[2 * e] * rstd, d[2 * e + 1] * rstd); w1[e] = pk2(d[8 + 2 * e] * rstd, d[8 + 2 * e + 1] * rstd); }
            v4u* dst = (v4u*)(OAN + t * 1024 + h * 128 + v0); dst[0] = w0; dst[1] = w1;
        }
    }
}

__device__ __forceinline__ void ml_load_conv(const Params& p, LAS float* dst, int b, int c, int ch0, float scale) {
    const bf16* QKM = (const bf16*)(p.ws + WS_QKM);
    for (int idx = threadIdx.x; idx < 4096; idx += NTHR) { const int s = idx >> 6, d = idx & 63, ch = ch0 + d; float val = p.conv_b[ch];
#pragma unroll
        for (int j = 0; j < 4; ++j) { const int tt = c * 64 + s - 3 + j; if (tt >= 0) val += p.conv_w[j * 1024 + ch] * bf2f(QKM[((size_t)b * SEQ + tt) * 1024 + ch]); }
        dst[s * 65 + d] = val * sigm_(val) * scale; }
}
__device__ __forceinline__ void ml_load_v(const Params& p, LAS float* dst, int b, int h, int c) {
    const bf16* VM = (const bf16*)(p.ws + WS_VM);
    for (int idx = threadIdx.x; idx < 64 * 64; idx += NTHR) { const int s = idx >> 6, v2 = (idx & 63) * 2;
        const unsigned w = *(const unsigned*)(VM + ((size_t)b * SEQ + c * 64 + s) * 1024 + h * 128 + v2); dst[s * 128 + v2] = bf_lo_(w); dst[s * 128 + v2 + 1] = bf_hi_(w); }
}
__device__ __forceinline__ void mlstm_a(const Params& p, LAS unsigned char* lds, int vcu) {
    LAS float* Kl = (LAS float*)lds; LAS float* Vl = Kl + 64 * 65; LAS float* wsl = Vl + 64 * 128;
    float* UST = (float*)(p.ws + WS_UST); float* NST = (float*)(p.ws + WS_NST); float* CHK = (float*)(p.ws + WS_CHK); const float* IFG = (const float*)(p.ws + WS_IFG);
    int tid = threadIdx.x; asm volatile("" : "+v"(tid)); const int lane = tid & 63, wave = tid >> 6;
    for (int item = vcu * 8; item < vcu * 8 + 8; ++item) {
        const int bh = item >> 6, c = item & 63, b = bh >> 3, h = bh & 7; const size_t t0 = (size_t)b * SEQ + c * 64;
        ml_load_conv(p, Kl, b, c, 512 + h * 64, 1.f); ml_load_v(p, Vl, b, h, c);
        if (wave == 0) { const float ig = IFG[(t0 + lane) * 16 + h], lf = IFG[(t0 + lane) * 16 + 8 + h]; float bs = lf;
#pragma unroll
            for (int o = 1; o < 64; o <<= 1) { const float t = __shfl_up(bs, o); if (lane >= o) bs += t; }
            const float bL = __shfl(bs, 63), wl = bL - bs + ig, mloc = wave_max(wl);
            wsl[lane] = __expf(wl - mloc); if (lane == 0) { CHK[item * 4 + 0] = mloc; CHK[item * 4 + 1] = bL; } }
        __syncthreads();
        const int d = tid >> 3, vb = (tid & 7) * 16; float acc[16]; float nacc = 0.f;
#pragma unroll
        for (int j = 0; j < 16; ++j) acc[j] = 0.f;
        for (int s = 0; s < 64; ++s) { const float kv = Kl[s * 65 + d] * wsl[s]; nacc += kv; const LAS f32x4* vr = (const LAS f32x4*)(Vl + s * 128 + vb);
#pragma unroll
            for (int q = 0; q < 4; ++q) { const f32x4 vv = vr[q]; acc[4 * q] += kv * vv.x; acc[4 * q + 1] += kv * vv.y; acc[4 * q + 2] += kv * vv.z; acc[4 * q + 3] += kv * vv.w; } }
        f32x4* up = (f32x4*)(UST + (size_t)item * 8192 + d * 128 + vb);
#pragma unroll
        for (int q = 0; q < 4; ++q) up[q] = (f32x4){acc[4 * q], acc[4 * q + 1], acc[4 * q + 2], acc[4 * q + 3]};
        if ((tid & 7) == 0) NST[item * 64 + d] = nacc;
        __syncthreads();
    }
}
__device__ __forceinline__ void mlstm_b(const Params& p) {
    float* UST = (float*)(p.ws + WS_UST); float* NST = (float*)(p.ws + WS_NST); float* CHK = (float*)(p.ws + WS_CHK);
    constexpr int PER = 8192 + 64, TOTAL = BATCH * NH * PER;
    for (int e = blockIdx.x * NTHR + threadIdx.x; e < TOTAL; e += GRID * NTHR) {
        const int bh = e / PER, idx = e % PER; float* ptr; int stride;
        if (idx < 8192) { ptr = UST + (size_t)bh * 64 * 8192 + idx; stride = 8192; } else { ptr = NST + (size_t)bh * 64 * 64 + (idx - 8192); stride = 64; }
        float C = 0.f, m = 0.f;
#pragma unroll 4
        for (int c = 0; c < NCHUNK; ++c) { const int item = bh * 64 + c; const float mloc = CHK[item * 4 + 0], g = CHK[item * 4 + 1];
            const float u = ptr[(size_t)c * stride]; ptr[(size_t)c * stride] = C; if (idx == 0) CHK[item * 4 + 2] = m;
            const float mn = fmaxf(g + m, mloc); C = __expf(g + m - mn) * C + __expf(mloc - mn) * u; m = mn; }
    }
}
__device__ __forceinline__ void mlstm_c(const Params& p, LAS unsigned char* lds, int vcu) {
    LAS float* Ql = (LAS float*)lds; LAS float* Kl = Ql + 64 * 65; LAS float* Vl = Kl + 64 * 65; LAS float* Cl = Vl + 64 * 128; LAS float* Sl = Cl + 64 * 128;
    LAS float* nl = Sl + 64 * 65; LAS float* bc = nl + 64; LAS float* igl = bc + 64; LAS float* mtl = igl + 64; LAS float* inl = mtl + 64;
    const float* UST = (const float*)(p.ws + WS_UST); const float* NST = (const float*)(p.ws + WS_NST); const float* CHK = (const float*)(p.ws + WS_CHK); const float* IFG = (const float*)(p.ws + WS_IFG);
    bf16* OB = (bf16*)(p.ws + WS_VM);
    int tid = threadIdx.x; asm volatile("" : "+v"(tid)); const int lane = tid & 63, wave = tid >> 6;
    for (int item = vcu * 8; item < vcu * 8 + 8; ++item) {
        const int bh = item >> 6, c = item & 63, b = bh >> 3, h = bh & 7; const size_t t0 = (size_t)b * SEQ + c * 64;
        ml_load_conv(p, Ql, b, c, h * 64, 0.125f); ml_load_conv(p, Kl, b, c, 512 + h * 64, 1.f); ml_load_v(p, Vl, b, h, c);
        for (int idx = tid; idx < 2048; idx += NTHR) ((LAS f32x4*)Cl)[idx] = ((const f32x4*)(UST + (size_t)item * 8192))[idx];
        if (tid < 64) nl[tid] = NST[item * 64 + tid];
        const float mc = CHK[item * 4 + 2];
        if (wave == 1) { const float ig = IFG[(t0 + lane) * 16 + h], lf = IFG[(t0 + lane) * 16 + 8 + h]; float bs = lf;
#pragma unroll
            for (int o = 1; o < 64; o <<= 1) { const float t = __shfl_up(bs, o); if (lane >= o) bs += t; }
            float pm = ig - bs;
#pragma unroll
            for (int o = 1; o < 64; o <<= 1) { const float t = __shfl_up(pm, o); if (lane >= o) pm = fmaxf(pm, t); }
            const float mt = bs + fmaxf(pm, mc);
            bc[lane] = bs; igl[lane] = ig; mtl[lane] = mt; inl[lane] = __expf(bs + mc - mt); }
        __syncthreads();
        for (int idx = tid; idx < 4096; idx += NTHR) { const int t = idx >> 6, s = idx & 63; float v = 0.f;
            if (s <= t) { float dot = 0.f;
#pragma unroll 16
                for (int d = 0; d < 64; ++d) dot += Ql[t * 65 + d] * Kl[s * 65 + d];
                v = dot * __expf(bc[t] - bc[s] + igl[s] - mtl[t]); }
            Sl[t * 65 + s] = v; }
        __syncthreads();
        const int t = tid >> 3, vb = (tid & 7) * 16; float acc[16], accC[16]; float den = 0.f, qn = 0.f;
#pragma unroll
        for (int j = 0; j < 16; ++j) { acc[j] = 0.f; accC[j] = 0.f; }
        for (int s = 0; s < 64; ++s) { const float sv = Sl[t * 65 + s]; den += sv; const LAS f32x4* vr = (const LAS f32x4*)(Vl + s * 128 + vb);
#pragma unroll
            for (int q = 0; q < 4; ++q) { const f32x4 vv = vr[q]; acc[4 * q] += sv * vv.x; acc[4 * q + 1] += sv * vv.y; acc[4 * q + 2] += sv * vv.z; acc[4 * q + 3] += sv * vv.w; } }
        for (int d = 0; d < 64; ++d) { const float qv = Ql[t * 65 + d]; qn += qv * nl[d]; const LAS f32x4* cr = (const LAS f32x4*)(Cl + d * 128 + vb);
#pragma unroll
            for (int q = 0; q < 4; ++q) { const f32x4 cv = cr[q]; accC[4 * q] += qv * cv.x; accC[4 * q + 1] += qv * cv.y; accC[4 * q + 2] += qv * cv.z; accC[4 * q + 3] += qv * cv.w; } }
        const float inter = inl[t], mt = mtl[t]; den += inter * qn;
        const float rden = 1.f / fmaxf(fabsf(den), __expf(-mt)); float ss = 0.f;
#pragma unroll
        for (int j = 0; j < 16; ++j) { acc[j] = (acc[j] + inter * accC[j]) * rden; ss += acc[j] * acc[j]; }
        ss += __shfl_xor(ss, 1); ss += __shfl_xor(ss, 2); ss += __shfl_xor(ss, 4);
        const float rstd = 1.f / sqrtf(ss * (1.f / 128.f) + EPS);
        __syncthreads();
        v4u w0, w1;
#pragma unroll
        for (int e = 0; e < 4; ++e) { w0[e] = pk2(acc[2 * e] * rstd, acc[2 * e + 1] * rstd); w1[e] = pk2(acc[8 + 2 * e] * rstd, acc[8 + 2 * e + 1] * rstd); }
        v4u* dst = (v4u*)(OB + (t0 + t) * 1024 + h * 128 + vb); dst[0] = w0; dst[1] = w1;
    }
}

__device__ __forceinline__ void final_norm(const Params& p, int vcu) {
    int tid_ = threadIdx.x; asm volatile("" : "+v"(tid_)); const int lane = tid_ & 63, wave = __builtin_amdgcn_readfirstlane(tid_ >> 6);
    const float* SS2 = (const float*)(p.ws + WS_SS2); const int gw = vcu * NWAVES + wave, NGW = GRID * NWAVES;
    for (int m = gw; m < T; m += NGW) {
        const f32x4 q = *(const f32x4*)(SS2 + (size_t)m * 4); const float rstd = 1.f / sqrtf(((q.x + q.y) + (q.z + q.w)) * (1.f / DM) + EPS);
        f32x4* xr = (f32x4*)(p.out + (size_t)m * DM) + lane; const f32x4* wr_ = (const f32x4*)p.final_w + lane;
#pragma unroll
        for (int j = 0; j < 4; ++j) { const f32x4 v = xr[64 * j], w = wr_[64 * j]; xr[64 * j] = v * rstd * w; }
    }
}

constexpr int LDS_BYTES = 147456;
__global__ void __launch_bounds__(NTHR, 2) mk_fwd(Params p) {
    extern __shared__ __attribute__((aligned(16))) unsigned char lds_raw[];
    LAS unsigned char* lds = (LAS unsigned char*)lds_raw;
    const int tid = threadIdx.x;
    const int bx = blockIdx.x, vcu = (bx % 8) * (GRID / 8) + bx / 8;
    unsigned char* ws = p.ws;
    bf16* XN = (bf16*)(ws + WS_XN); bf16* WTIN = (bf16*)(ws + WS_WTIN);
    const int lo = p.ph_lo, hi = p.ph_hi;
    volatile LAS unsigned* MISC = (volatile LAS unsigned*)(lds + LDS_BYTES - 64);
    if (tid < 16) MISC[tid] = 0u;
    __syncthreads();
    XcdBarrier bar; bar.bar = (unsigned*)(ws) + CW_BAR; bar.x = 0; bar.st = nullptr;
    if (hi - lo > 1) bar = xcd_barrier_post((unsigned*)(ws) + CW_BAR, MISC);
#define IN(k) (lo <= (k) && (k) < hi)
#define SEAM(k) do { if (IN(k) && IN((k) + 1)) xcd_barrier(bar); } while (0)
#if (PH_MASK >> 0) & 1
        if (IN(0)) { p0_prologue(p, lds, vcu); } SEAM(0);
#endif
#if (PH_MASK >> 1) & 1
        if (IN(1)) { {
            pg8::Gemm g{XN, WTIN, T, 5120, DM, nullptr, 1 << 30}; pg8::StaticOrder S; S.init(T, 5120, GRID, bx);
            pg8::EpiInProj E{(bf16*)(ws + WS_QA), (size_t)T * 1024, (const float*)(ws + WS_ROPE), QSCALE};
            pg8::gemm_phase<pg8::EpiInProj, pg8::StaticOrder, true, true>(lds, g, S, E);
            p1_gates(p, vcu);
        } } SEAM(1);
#endif
#if (PH_MASK >> 2) & 1
        if (IN(2)) { attn_phase(p, (char*)lds_raw, vcu); } SEAM(2);
#endif
#if (PH_MASK >> 3) & 1
        if (IN(3)) { mlstm_a(p, lds, vcu); } SEAM(3);
#endif
#if (PH_MASK >> 4) & 1
        if (IN(4)) { mlstm_b(p); } SEAM(4);
#endif
#if (PH_MASK >> 5) & 1
        if (IN(5)) { mlstm_c(p, lds, vcu); } SEAM(5);
#endif
#if (PH_MASK >> 6) & 1
        if (IN(6)) { {
            pg8::Gemm g{XN, WTIN + (size_t)5120 * 1024, T, 1024, DM, nullptr, 1 << 30}; pg8::StaticOrder S; S.init(T, 1024, GRID, bx);
            pg8::EpiSigMul E{(bf16*)(ws + WS_VM), 1024};
            pg8::gemm_phase<pg8::EpiSigMul, pg8::StaticOrder, true, true>(lds, g, S, E);
        } } SEAM(6);
#endif
#if (PH_MASK >> 7) & 1
        if (IN(7)) { {
            pg8::Gemm g{(const bf16*)(ws + WS_QA), (const bf16*)(ws + WS_WTAB), T, 2048, DM, (const bf16*)(ws + WS_VM), 4}; pg8::StaticOrder S; S.init(T, 2048, GRID, bx);
            pg8::EpiBf16<0> E{(bf16*)(ws + WS_Y), 2048, nullptr, 0, 0, 1.f};
            pg8::gemm_phase<pg8::EpiBf16<0>, pg8::StaticOrder, true, true>(lds, g, S, E);
        } } SEAM(7);
#endif
#if (PH_MASK >> 8) & 1
        if (IN(8)) { {
            pg8::Gemm g{XN, WTIN + (size_t)6144 * 1024, T, 2048, DM, nullptr, 1 << 30}; pg8::StaticOrder S; S.init(T, 2048, GRID, bx);
            pg8::EpiSigMul E{(bf16*)(ws + WS_Y), 2048};
            pg8::gemm_phase<pg8::EpiSigMul, pg8::StaticOrder, true, true>(lds, g, S, E);
        } } SEAM(8);
#endif
#if (PH_MASK >> 9) & 1
        if (IN(9)) { {
            pg8::Gemm g{(const bf16*)(ws + WS_Y), (const bf16*)(ws + WS_WTOUT), T, 1024, 2048, nullptr, 1 << 30}; pg8::StaticOrder S; S.init(T, 1024, GRID, bx);
            pg8::EpiRes E{p.x, p.out, (bf16*)(ws + WS_HB), (float*)(ws + WS_SS1)};
            pg8::gemm_phase<pg8::EpiRes, pg8::StaticOrder, false, true>(lds, g, S, E);
        } } SEAM(9);
#endif
#if (PH_MASK >> 10) & 1
        if (IN(10)) { {
            pg8::Gemm g{(const bf16*)(ws + WS_HB), (const bf16*)(ws + WS_WTFF1), T, FF, DM, nullptr, 1 << 30}; pg8::StaticOrder S; S.init(T, FF, GRID, bx);
            pg8::EpiFF1 E{(bf16*)(ws + WS_U), FF, (const float*)(ws + WS_SS1), EPS};
            pg8::gemm_phase<pg8::EpiFF1, pg8::StaticOrder, true, true>(lds, g, S, E);
        } } SEAM(10);
#endif
#if (PH_MASK >> 11) & 1
        if (IN(11)) { {
            pg8::Gemm g{(const bf16*)(ws + WS_U), (const bf16*)(ws + WS_WTFF2), T, 1024, FF, nullptr, 1 << 30}; pg8::StaticOrder S; S.init(T, 1024, GRID, bx);
            pg8::EpiRes E{p.out, p.out, nullptr, (float*)(ws + WS_SS2)};
            pg8::gemm_phase<pg8::EpiRes, pg8::StaticOrder, false, true>(lds, g, S, E);
        } } SEAM(11);
#endif
#if (PH_MASK >> 12) & 1
        if (IN(12)) { final_norm(p, vcu); } SEAM(12);
#endif
#undef IN
#undef SEAM
}

extern "C" void kernel_launch(void* const* d_in, const int* in_sizes, int n_in, void* d_out, int out_size, void* d_ws, size_t ws_size, hipStream_t stream) {
    static int ready = 0;
    if (!ready) {
        if (n_in != 17 || in_sizes[0] != T * DM || out_size != T * DM || ws_size < WS_END) { fprintf(stderr, "kernel_launch: unexpected shapes (n_in %d in0 %d out %d ws %zu)\n", n_in, n_in > 0 ? in_sizes[0] : -1, out_size, ws_size); ready = -1; return; }
        if (hipFuncSetAttribute((const void*)mk_fwd, hipFuncAttributeMaxDynamicSharedMemorySize, LDS_BYTES) != hipSuccess) { fprintf(stderr, "kernel_launch: hipFuncSetAttribute failed\n"); ready = -1; return; }
        int per_cu = 0; (void)hipOccupancyMaxActiveBlocksPerMultiprocessor(&per_cu, (const void*)mk_fwd, NTHR, LDS_BYTES); (void)hipGetLastError();
        int dev = 0, cus = 0; (void)hipGetDevice(&dev); (void)hipDeviceGetAttribute(&cus, hipDeviceAttributeMultiprocessorCount, dev);
        if (per_cu < 1 || cus < GRID) fprintf(stderr, "kernel_launch: note: occupancy %d blocks/CU, %d CUs (need 1 x %d)\n", per_cu, cus, GRID);
        ready = 1;
    }
    if (ready < 0) return;
    Params p{};
    p.x = (const float*)d_in[0]; p.pos = (const int*)d_in[1]; p.norm_mix_w = (const float*)d_in[2]; p.w_in = (const float*)d_in[3]; p.gate_b = (const float*)d_in[4];
    p.conv_w = (const float*)d_in[5]; p.conv_b = (const float*)d_in[6]; p.da_lambda = (const float*)d_in[7]; p.subln_w = (const float*)d_in[8]; p.ml_norm_w = (const float*)d_in[9];
    p.w_a = (const float*)d_in[10]; p.w_b = (const float*)d_in[11]; p.w_out = (const float*)d_in[12]; p.norm_ffn_w = (const float*)d_in[13]; p.w_ff1 = (const float*)d_in[14];
    p.w_ff2 = (const float*)d_in[15]; p.final_w = (const float*)d_in[16]; p.out = (float*)d_out; p.ws = (unsigned char*)d_ws;
#if MK_PER_PHASE
    for (int ph = 0; ph < NPHASE; ++ph) { p.ph_lo = ph; p.ph_hi = ph + 1; hipLaunchKernelGGL(mk_fwd, dim3(GRID), dim3(NTHR), LDS_BYTES, stream, p); }
#else
    if (hipMemsetAsync(d_ws, 0, 1 * MiB, stream) != hipSuccess) { fprintf(stderr, "kernel_launch: memset of the control words failed\n"); return; }
    p.ph_lo = 0; p.ph_hi = NPHASE; void* args[] = {&p};
    hipError_t e = hipLaunchCooperativeKernel((const void*)mk_fwd, dim3(GRID), dim3(NTHR), args, LDS_BYTES, stream);
    if (e != hipSuccess) fprintf(stderr, "cooperative launch failed: %s\n", hipGetErrorString(e));
#endif
}
```

```cpp
#include <hip/hip_runtime.h>
#include <cstdio>
#include <cstdint>
namespace pg8 {
#define PG8_LAS __attribute__((address_space(3)))
typedef unsigned short bf16_t;
typedef short bf16x8 __attribute__((ext_vector_type(8)));
typedef float f32x4 __attribute__((ext_vector_type(4)));
typedef unsigned u32x4 __attribute__((ext_vector_type(4)));
constexpr int BM = 256, BK = 64, HALF = 128, HTB = HALF * BK * 2  , STAGE_BYTES = 8 * HTB, NXCD = 8, WGM = 8;

__host__ __device__ __forceinline__ int lds_byte(int r, int c) { const int st = (r >> 4) * 2 + (c >> 5), rr = r & 15, cc = c & 31, ob = rr * 64 + cc * 2; return st * 1024 + (ob ^ (((ob >> 9) & 1) << 5)); }
__host__ __device__ __forceinline__ void stage_rc(int b, int& R, int& C) { const int st = b / 1024, sb = b % 1024, swz = sb ^ (((sb >> 9) & 1) << 5); R = (st >> 1) * 16 + swz / 64; C = (st & 1) * 32 + (swz % 64) / 2; }
__host__ __device__ __forceinline__ int perm32(int rho) { const int n = rho >> 4, i = rho & 15; return 8 * (i >> 2) + 4 * n + (i & 3); }

struct Unit { int pm, pn; };
struct Gemm { const bf16_t* A; const bf16_t* Bt; int M, N, K; const bf16_t* A2; int pn_split; };

struct StaticOrder {
    int nM, nN, nwg, G, c;
    __host__ __device__ void init(int M, int N, int G_, int c_) { nM = M / BM; nN = N / BM; nwg = nM * nN; G = G_; c = c_; }
    __host__ __device__ bool next(int i, Unit& u) const {
        const long L = (long)i * G + c; if (L >= nwg) return false;
        int wgid = (int)L; { const int q = nwg / NXCD, r = nwg % NXCD, xcd = wgid % NXCD, off = wgid / NXCD; wgid = (xcd < r ? xcd * (q + 1) : r * (q + 1) + (xcd - r) * q) + off; }
        const int nig = WGM * nN, gid = wgid / nig, fm = gid * WGM, gsz = (nM - fm) < WGM ? (nM - fm) : WGM;
        u.pm = fm + ((wgid % nig) % gsz); u.pn = (wgid % nig) / gsz; return true;
    }
    __device__ __forceinline__ void a_ready(const Unit&) const {}
    __device__ __forceinline__ void done(const Unit&) const {}
};

__device__ __forceinline__ unsigned cvt_pk_bf16(float lo, float hi) { unsigned r; asm volatile("v_cvt_pk_bf16_f32 %0, %1, %2" : "=v"(r) : "v"(lo), "v"(hi)); return r; }
typedef float f32x2 __attribute__((ext_vector_type(2)));
__device__ __forceinline__ f32x2 gelu_pk(f32x2 v) {
    const f32x2 av = __builtin_elementwise_abs(v), d = av * 0.2316418882f + 1.0f;
    f32x2 t; t.x = __builtin_amdgcn_rcpf(d.x); t.y = __builtin_amdgcn_rcpf(d.y);
    f32x2 q = t * 0.5307027145f + (-0.7265760135f); q = q * t + 0.7107068705f; q = q * t + (-0.142248368f); q = q * t + 0.127414796f; q = q * t;
    const f32x2 s = (v * v) * (-0.72134752044f);
    f32x2 e; e.x = __builtin_amdgcn_exp2f(s.x); e.y = __builtin_amdgcn_exp2f(s.y);
    const f32x2 m = v * (q * e), r = v - m;
    f32x2 o; o.x = v.x < 0.f ? m.x : r.x; o.y = v.y < 0.f ? m.y : r.y; return o;
}

template <int ACT  > struct EpiBf16 {
    static constexpr bool PERM = true, AFTER_DRAIN = false; static_assert(ACT == 0 || ACT == 1, "EpiBf16: ACT is 0 (none) or 1 (gelu_pk)");
    bf16_t* O; int ldc; const float* bias; int split_cols; size_t split_stride; float scale0;
    __device__ __forceinline__ void operator()(const f32x4 (&acc)[2][2][4][2], const Unit& u, int wr, int wc, int fr, int fq) const {
        const int row0 = u.pm * BM + wr * 64 + fr; int colt = u.pn * BM; bf16_t* base = O;
        float sc = 1.f; if (split_cols) { const int t = colt / split_cols; base += (size_t)t * split_stride; colt -= t * split_cols; if (t == 0) sc = scale0; }
        const int col0 = colt + wc * 32 + 8 * fq, bcol0 = u.pn * BM + wc * 32 + 8 * fq;
        f32x4 bv[2][2];
#pragma unroll
        for (int bj = 0; bj < 2; ++bj)
#pragma unroll
            for (int n = 0; n < 2; ++n) bv[bj][n] = bias ? *(const f32x4*)(bias + bcol0 + bj * HALF + 4 * n) : (f32x4){0.f, 0.f, 0.f, 0.f};
#pragma unroll
        for (int ai = 0; ai < 2; ++ai)
#pragma unroll
            for (int m = 0; m < 4; ++m) { bf16_t* rowp = base + (size_t)(row0 + ai * HALF + m * 16) * ldc + col0;
#pragma unroll
                for (int bj = 0; bj < 2; ++bj) { f32x4 v0 = acc[ai][bj][m][0] + bv[bj][0], v1 = acc[ai][bj][m][1] + bv[bj][1];
                    if (ACT == 1) { f32x2 a = gelu_pk((f32x2){v0[0], v0[1]}), b = gelu_pk((f32x2){v0[2], v0[3]}), c = gelu_pk((f32x2){v1[0], v1[1]}), d = gelu_pk((f32x2){v1[2], v1[3]});
                        v0 = (f32x4){a.x, a.y, b.x, b.y}; v1 = (f32x4){c.x, c.y, d.x, d.y}; }
                    v0 = v0 * sc; v1 = v1 * sc; u32x4 w; w.x = cvt_pk_bf16(v0[0], v0[1]); w.y = cvt_pk_bf16(v0[2], v0[3]); w.z = cvt_pk_bf16(v1[0], v1[1]); w.w = cvt_pk_bf16(v1[2], v1[3]);
                    *(u32x4*)(rowp + bj * HALF) = w; } }
    }
};


__device__ __forceinline__ float sigm(float x) { return __builtin_amdgcn_rcpf(1.f + __builtin_amdgcn_exp2f(-1.4426950408889634f * x)); }
__device__ __forceinline__ float bf_lo(unsigned w) { return __uint_as_float(w << 16); }
__device__ __forceinline__ float bf_hi(unsigned w) { return __uint_as_float(w & 0xffff0000u); }

struct EpiInProj {
    static constexpr bool PERM = true, AFTER_DRAIN = false;
    bf16_t* base0; size_t bufstride; const float* rope; float qscale;
    __device__ __forceinline__ void operator()(const f32x4 (&acc)[2][2][4][2], const Unit& u, int wr, int wc, int fr, int fq) const {
        const int buf = u.pn >> 2; bf16_t* base = base0 + (size_t)buf * bufstride;
        const int row0 = u.pm * BM + wr * 64 + fr, col0 = (u.pn & 3) * 256 + wc * 32 + 8 * fq;
        const bool ropew = (buf < 2) && ((wc & 1) == 0);
        const float sc = (buf == 0) ? qscale : 1.f;
#pragma unroll
        for (int ai = 0; ai < 2; ++ai)
#pragma unroll
            for (int m = 0; m < 4; ++m) {
                const int row = row0 + ai * HALF + m * 16; bf16_t* rowp = base + (size_t)row * 1024 + col0;
                f32x4 c0 = {1.f, 1.f, 1.f, 1.f}, c1 = c0, s0 = {0.f, 0.f, 0.f, 0.f}, s1 = s0;
                if (ropew) { const f32x4* rp = (const f32x4*)(rope + (size_t)row * 16); c0 = rp[0]; c1 = rp[1]; s0 = rp[2]; s1 = rp[3]; }
#pragma unroll
                for (int bj = 0; bj < 2; ++bj) {
                    f32x4 v0 = acc[ai][bj][m][0], v1 = acc[ai][bj][m][1];
                    if (ropew) {
                        f32x4 p0, p1;
#pragma unroll
                        for (int e = 0; e < 4; ++e) { p0[e] = __shfl_xor(v0[e], 16); p1[e] = __shfl_xor(v1[e], 16); }
                        if (fq == 0) { v0 = v0 * c0 - p0 * s0; v1 = v1 * c1 - p1 * s1; }
                        else if (fq == 1) { v0 = v0 * c0 + p0 * s0; v1 = v1 * c1 + p1 * s1; }
                    }
                    v0 = v0 * sc; v1 = v1 * sc;
                    u32x4 w; w.x = cvt_pk_bf16(v0[0], v0[1]); w.y = cvt_pk_bf16(v0[2], v0[3]); w.z = cvt_pk_bf16(v1[0], v1[1]); w.w = cvt_pk_bf16(v1[2], v1[3]);
                    *(u32x4*)(rowp + bj * HALF) = w;
                }
            }
    }
};
struct EpiSigMul {
    static constexpr bool PERM = true, AFTER_DRAIN = false;
    bf16_t* O; int ldc;
    __device__ __forceinline__ void operator()(const f32x4 (&acc)[2][2][4][2], const Unit& u, int wr, int wc, int fr, int fq) const {
        const int row0 = u.pm * BM + wr * 64 + fr, col0 = u.pn * BM + wc * 32 + 8 * fq;
#pragma unroll
        for (int ai = 0; ai < 2; ++ai)
#pragma unroll
            for (int m = 0; m < 4; ++m) {
                bf16_t* rowp = O + (size_t)(row0 + ai * HALF + m * 16) * ldc + col0;
#pragma unroll
                for (int bj = 0; bj < 2; ++bj) {
                    const u32x4 old = *(const u32x4*)(rowp + bj * HALF);
                    const f32x4 v0 = acc[ai][bj][m][0], v1 = acc[ai][bj][m][1];
                    u32x4 w;
                    w.x = cvt_pk_bf16(sigm(v0[0]) * bf_lo(old.x), sigm(v0[1]) * bf_hi(old.x));
                    w.y = cvt_pk_bf16(sigm(v0[2]) * bf_lo(old.y), sigm(v0[3]) * bf_hi(old.y));
                    w.z = cvt_pk_bf16(sigm(v1[0]) * bf_lo(old.z), sigm(v1[1]) * bf_hi(old.z));
                    w.w = cvt_pk_bf16(sigm(v1[2]) * bf_lo(old.w), sigm(v1[3]) * bf_hi(old.w));
                    *(u32x4*)(rowp + bj * HALF) = w;
                }
            }
    }
};
struct EpiFF1 {
    static constexpr bool PERM = true, AFTER_DRAIN = false;
    bf16_t* O; int ldc; const float* ss; float eps;
    __device__ __forceinline__ void operator()(const f32x4 (&acc)[2][2][4][2], const Unit& u, int wr, int wc, int fr, int fq) const {
        const int row0 = u.pm * BM + wr * 64 + fr, col0 = u.pn * BM + wc * 32 + 8 * fq;
#pragma unroll
        for (int ai = 0; ai < 2; ++ai)
#pragma unroll
            for (int m = 0; m < 4; ++m) {
                const int row = row0 + ai * HALF + m * 16; bf16_t* rowp = O + (size_t)row * ldc + col0;
                const f32x4 q = *(const f32x4*)(ss + (size_t)row * 4);
                const float rstd = __builtin_amdgcn_rsqf(((q[0] + q[1]) + (q[2] + q[3])) * (1.0f / 1024.0f) + eps);
#pragma unroll
                for (int bj = 0; bj < 2; ++bj) {
                    f32x4 v0 = acc[ai][bj][m][0] * rstd, v1 = acc[ai][bj][m][1] * rstd;
#pragma unroll
                    for (int e = 0; e < 4; ++e) { const float a = fmaxf(v0[e], 0.f), b = fmaxf(v1[e], 0.f); v0[e] = a * a; v1[e] = b * b; }
                    u32x4 w; w.x = cvt_pk_bf16(v0[0], v0[1]); w.y = cvt_pk_bf16(v0[2], v0[3]); w.z = cvt_pk_bf16(v1[0], v1[1]); w.w = cvt_pk_bf16(v1[2], v1[3]);
                    *(u32x4*)(rowp + bj * HALF) = w;
                }
            }
    }
};
struct EpiRes {
    static constexpr bool PERM = false, AFTER_DRAIN = true;
    const float* base; float* out; bf16_t* outb; float* ss;
    __device__ __forceinline__ void fused(f32x4 (&acc)[2][2][4][2], const Unit& u, int wr, int wc, int fr, int fq, PG8_LAS unsigned char* lds, int wid, int lane) const {
        typedef unsigned u32x2v __attribute__((ext_vector_type(2)));
        PG8_LAS float* P = (PG8_LAS float*)lds;
        const int col0 = u.pn * BM + wc * 32 + 4 * fq;
#pragma unroll
        for (int ai = 0; ai < 2; ++ai)
#pragma unroll
            for (int m = 0; m < 4; ++m) {
                const int r = ai * HALF + wr * 64 + m * 16 + fr; const size_t off = (size_t)(u.pm * BM + r) * 1024 + col0; float s = 0.f;
#pragma unroll
                for (int bj = 0; bj < 2; ++bj)
#pragma unroll
                    for (int n = 0; n < 2; ++n) {
                        const f32x4 bs = *(const f32x4*)(base + off + bj * HALF + n * 16); const f32x4 o = bs + acc[ai][bj][m][n];
                        *(f32x4*)(out + off + bj * HALF + n * 16) = o; s += (o[0] * o[0] + o[1] * o[1]) + (o[2] * o[2] + o[3] * o[3]);
                        if (outb) { u32x2v w; w.x = cvt_pk_bf16(o[0], o[1]); w.y = cvt_pk_bf16(o[2], o[3]); *(u32x2v*)(outb + off + bj * HALF + n * 16) = w; }
                    }
                s += __shfl_xor(s, 16); s += __shfl_xor(s, 32);
                if (fq == 0) P[r * 4 + wc] = s;
                if (m & 1) asm volatile("" ::: "memory");
            }
        asm volatile("s_waitcnt lgkmcnt(0)" ::: "memory"); __builtin_amdgcn_s_barrier(); asm volatile("" ::: "memory");
        const int tid = wid * 64 + lane;
        if (tid < 256) { const float t = (P[tid * 4 + 0] + P[tid * 4 + 1]) + (P[tid * 4 + 2] + P[tid * 4 + 3]); ss[(size_t)(u.pm * BM + tid) * 4 + u.pn] = t; }
        asm volatile("s_waitcnt lgkmcnt(0)" ::: "memory"); __builtin_amdgcn_s_barrier(); asm volatile("" ::: "memory");
    }
};
template <class Epi, class Sched, bool ALIGN_EPI = false, bool SP2 = false>
__device__ __forceinline__ void gemm_phase(PG8_LAS unsigned char* lds, const Gemm g, const Sched& S, const Epi& E) {
    const int tid = threadIdx.x, wid = __builtin_amdgcn_readfirstlane(tid >> 6), lane = tid & 63, wr = wid >> 2, wc = wid & 3, fr = lane & 15, fq = lane >> 4;
    const int K = g.K, nt = K / BK;
    unsigned voffA[2], voffB[2];
#pragma unroll
    for (int i = 0; i < 2; ++i) { int R, C; stage_rc(tid * 16 + i * 8192, R, C); const int Rb = Epi::PERM ? ((R & ~31) + perm32(R & 31)) : R;
        voffA[i] = (unsigned)(R * K + C) * 2u; voffB[i] = (unsigned)(Rb * K + C) * 2u; }
    const size_t kstep = (size_t)(BK * 2);
    const size_t hstep = (size_t)HALF * K * 2;
    const size_t tstep = 2 * hstep;
    const unsigned ldsw = (unsigned)wid * 1024u;
    const int aoff = lds_byte(wr * 64 + fr, fq * 8), boff = lds_byte(wc * 32 + fr, fq * 8);
#define PG8_SA(b, h) (((b) * 2 + (h)) * HTB)
#define PG8_SB(b, h) ((4 + (b) * 2 + (h)) * HTB)
#define PG8_STAGE(bufoff, gbase, voff) do { _Pragma("unroll") for (int _i = 0; _i < 2; ++_i) \
        __builtin_amdgcn_global_load_lds((const unsigned*)((const char*)(gbase) + (voff)[_i]), (PG8_LAS unsigned*)(lds + (bufoff) + ldsw + _i * 8192), 16, 0, 0); } while (0)
#define PG8_LDA(dst, b, h) do { _Pragma("unroll") for (int m = 0; m < 4; ++m) _Pragma("unroll") for (int k = 0; k < 2; ++k) dst[m][k] = *(const PG8_LAS bf16x8*)(lds + PG8_SA(b, h) + aoff + m * 2048 + k * 1024); } while (0)
#define PG8_LDB(dst, b, h) do { _Pragma("unroll") for (int n = 0; n < 2; ++n) _Pragma("unroll") for (int k = 0; k < 2; ++k) dst[n][k] = *(const PG8_LAS bf16x8*)(lds + PG8_SB(b, h) + boff + n * 2048 + k * 1024); } while (0)
#define PG8_MMA(ai, bj, At, Bt) do { __builtin_amdgcn_s_setprio(1); _Pragma("unroll") for (int m = 0; m < 4; ++m) _Pragma("unroll") for (int n = 0; n < 2; ++n) _Pragma("unroll") for (int k = 0; k < 2; ++k) \
        acc[ai][bj][m][n] = __builtin_amdgcn_mfma_f32_16x16x32_bf16(Bt[n][k], At[m][k], acc[ai][bj][m][n], 0, 0, 0); __builtin_amdgcn_s_setprio(0); } while (0)
#define PG8_WAIT_V(n) asm volatile("s_waitcnt vmcnt(" #n ")" ::: "memory")
#define PG8_WAIT_L(n) asm volatile("s_waitcnt lgkmcnt(" #n ")" ::: "memory")
#define PG8_BAR __builtin_amdgcn_s_barrier()
#define PG8_SCHED __builtin_amdgcn_sched_barrier(0)
    Unit cur, nxt; int ui = 0;
    if (!S.next(0, cur)) return;
    f32x4 acc[2][2][4][2];
#pragma unroll
    for (int a = 0; a < 2; ++a)
#pragma unroll
        for (int b = 0; b < 2; ++b)
#pragma unroll
            for (int m = 0; m < 4; ++m)
#pragma unroll
                for (int n = 0; n < 2; ++n) acc[a][b][m][n] = (f32x4){0.f, 0.f, 0.f, 0.f};
    bf16x8 At[4][2], B0[2][2], B1[2][2];
    const char* cA = (const char*)(cur.pn >= g.pn_split ? g.A2 : g.A) + (size_t)cur.pm * tstep; const char* cB = (const char*)g.Bt + (size_t)cur.pn * tstep;
    S.a_ready(cur);
    if constexpr (SP2) {
        PG8_STAGE(PG8_SB(0, 0), cB, voffB); PG8_STAGE(PG8_SB(0, 1), cB + hstep, voffB); PG8_STAGE(PG8_SA(0, 0), cA, voffA); PG8_STAGE(PG8_SA(0, 1), cA + hstep, voffA);
        if (wr == 1) PG8_BAR;
        PG8_WAIT_V(2); PG8_BAR;
        PG8_STAGE(PG8_SB(1, 0), cB + kstep, voffB); PG8_STAGE(PG8_SA(1, 0), cA + kstep, voffA); PG8_STAGE(PG8_SB(1, 1), cB + hstep + kstep, voffB);
        PG8_WAIT_V(6); PG8_BAR;
    } else {
        PG8_STAGE(PG8_SB(0, 0), cB, voffB); PG8_STAGE(PG8_SA(0, 0), cA, voffA); PG8_STAGE(PG8_SB(0, 1), cB + hstep, voffB); PG8_STAGE(PG8_SA(0, 1), cA + hstep, voffA);
        if (wr == 1) PG8_BAR;
        PG8_WAIT_V(4); PG8_BAR;
        PG8_STAGE(PG8_SB(1, 0), cB + kstep, voffB); PG8_STAGE(PG8_SA(1, 0), cA + kstep, voffA); PG8_STAGE(PG8_SB(1, 1), cB + hstep + kstep, voffB);
        PG8_WAIT_V(6); PG8_BAR;
    }
    for (;;) {
        const bool has_next = S.next(ui + 1, nxt);
        const char* nA = has_next ? (const char*)(nxt.pn >= g.pn_split ? g.A2 : g.A) + (size_t)nxt.pm * tstep : cA; const char* nB = has_next ? (const char*)g.Bt + (size_t)nxt.pn * tstep : cB;
        for (int t = 0; t < nt; t += 2) {
            const bool last = (t == nt - 2);
            const char* a1 = cA + (size_t)(t + 1) * kstep;
            const char* a2 = last ? nA : cA + (size_t)(t + 2) * kstep; const char* b2 = last ? nB : cB + (size_t)(t + 2) * kstep;
            const char* a3 = a2 + kstep; const char* b3 = b2 + kstep;
            if (last && has_next) S.a_ready(nxt);
            if constexpr (SP2) {
            PG8_LDB(B0, 0, 0); PG8_LDB(B1, 0, 1); PG8_SCHED; PG8_LDA(At, 0, 0); PG8_STAGE(PG8_SA(1, 1), a1 + hstep, voffA);
            PG8_WAIT_V(8); PG8_WAIT_L(0); PG8_BAR; PG8_MMA(0, 0, At, B0); PG8_MMA(0, 1, At, B1); PG8_BAR; PG8_SCHED;
            PG8_LDA(At, 0, 1); PG8_STAGE(PG8_SB(0, 0), b2, voffB); PG8_STAGE(PG8_SB(0, 1), b2 + hstep, voffB); PG8_STAGE(PG8_SA(0, 0), a2, voffA);
            PG8_WAIT_V(8); PG8_WAIT_L(0); PG8_BAR; PG8_MMA(1, 0, At, B0); PG8_MMA(1, 1, At, B1); PG8_BAR; PG8_SCHED;
            PG8_LDB(B0, 1, 0); PG8_LDB(B1, 1, 1); PG8_SCHED; PG8_LDA(At, 1, 0); PG8_STAGE(PG8_SA(0, 1), a2 + hstep, voffA);
            PG8_WAIT_V(8); PG8_WAIT_L(0); PG8_BAR; PG8_MMA(0, 0, At, B0); PG8_MMA(0, 1, At, B1); PG8_BAR; PG8_SCHED;
            PG8_LDA(At, 1, 1); PG8_STAGE(PG8_SB(1, 0), b3, voffB); PG8_STAGE(PG8_SB(1, 1), b3 + hstep, voffB); PG8_STAGE(PG8_SA(1, 0), a3, voffA);
            PG8_WAIT_V(8); PG8_WAIT_L(0); PG8_BAR; PG8_MMA(1, 0, At, B0); PG8_MMA(1, 1, At, B1); PG8_BAR; PG8_SCHED;
            } else {
            PG8_LDB(B0, 0, 0); PG8_SCHED; PG8_LDA(At, 0, 0); PG8_STAGE(PG8_SA(1, 1), a1 + hstep, voffA);
            PG8_WAIT_L(8); PG8_BAR; PG8_WAIT_L(0); PG8_MMA(0, 0, At, B0); PG8_BAR; PG8_SCHED;
            PG8_LDB(B1, 0, 1); PG8_STAGE(PG8_SB(0, 0), b2, voffB);
            PG8_BAR; PG8_WAIT_L(0); PG8_MMA(0, 1, At, B1); PG8_BAR;
            PG8_LDA(At, 0, 1); PG8_STAGE(PG8_SA(0, 0), a2, voffA);
            PG8_BAR; PG8_WAIT_L(0); PG8_MMA(1, 0, At, B0); PG8_BAR; PG8_SCHED;
            PG8_STAGE(PG8_SB(0, 1), b2 + hstep, voffB);
            PG8_WAIT_V(6); PG8_BAR; PG8_MMA(1, 1, At, B1); PG8_BAR;
            PG8_LDB(B0, 1, 0); PG8_SCHED; PG8_LDA(At, 1, 0); PG8_STAGE(PG8_SA(0, 1), a2 + hstep, voffA);
            PG8_WAIT_L(8); PG8_BAR; PG8_WAIT_L(0); PG8_MMA(0, 0, At, B0); PG8_BAR; PG8_SCHED;
            PG8_LDB(B1, 1, 1); PG8_STAGE(PG8_SB(1, 0), b3, voffB);
            PG8_BAR; PG8_WAIT_L(0); PG8_MMA(0, 1, At, B1); PG8_BAR;
            PG8_LDA(At, 1, 1); PG8_STAGE(PG8_SA(1, 0), a3, voffA);
            PG8_BAR; PG8_WAIT_L(0); PG8_MMA(1, 0, At, B0); PG8_BAR; PG8_SCHED;
            PG8_STAGE(PG8_SB(1, 1), b3 + hstep, voffB);
            PG8_WAIT_V(6); PG8_BAR; PG8_MMA(1, 1, At, B1); PG8_BAR;
            }
        }
        if constexpr (ALIGN_EPI) { if (wr == 0) PG8_BAR; }
        if constexpr (!Epi::AFTER_DRAIN) { E(acc, cur, wr, wc, fr, fq); S.done(cur); }
        if (!has_next) break;
#pragma unroll
        for (int a = 0; a < 2; ++a)
#pragma unroll
            for (int b = 0; b < 2; ++b)
#pragma unroll
                for (int m = 0; m < 4; ++m)
#pragma unroll
                    for (int n = 0; n < 2; ++n) acc[a][b][m][n] = (f32x4){0.f, 0.f, 0.f, 0.f};
        cur = nxt; cA = nA; cB = nB; ++ui;
        if constexpr (ALIGN_EPI) { if (wr == 1) PG8_BAR; }
    }
    PG8_WAIT_V(0);
    if constexpr (!ALIGN_EPI) { if (wr == 0) PG8_BAR; }
    PG8_BAR;
    if constexpr (Epi::AFTER_DRAIN) { E.fused(acc, cur, wr, wc, fr, fq, lds, wid, lane); S.done(cur); }
#undef PG8_SA
#undef PG8_SB
#undef PG8_STAGE
#undef PG8_LDA
#undef PG8_LDB
#undef PG8_MMA
#undef PG8_WAIT_V
#undef PG8_WAIT_L
#undef PG8_BAR
#undef PG8_SCHED
}
}
#include <hip/hip_bf16.h>
#include <cmath>
namespace attn_body {
using bf16=__hip_bfloat16;
using bf16x8=__attribute__((ext_vector_type(8)))short;
using s16x4=__attribute__((ext_vector_type(4)))short;
using f32x16=__attribute__((ext_vector_type(16)))float;
using u32x4=__attribute__((ext_vector_type(4)))unsigned;
constexpr int BATCH=4,SEQ=4096,D=64,DM=1024,OPITCH=2048;
constexpr int NW=8,QBLK=32,QB=QBLK*NW,KVBLK=64,NQB=SEQ/QB;
constexpr int ATTN_PITCH=DM, ATTN_UNIT_ROWS=QB;
__device__ __forceinline__ int crow(int r,int hi){return (r&3)+8*(r>>2)+4*hi;}
#define SBAR() __builtin_amdgcn_sched_barrier(0)
__device__ __forceinline__ void cmask(f32x16&p0,f32x16&p1,int jb,int qrel,int hi){
  const float NEG=-INFINITY; int kb=64*jb+4*hi;
  #pragma unroll
  for(int r=0;r<16;++r){int kv=kb+(r&3)+8*(r>>2); if(kv>qrel)p0[r]=NEG; if(kv+32>qrel)p1[r]=NEG;}
}

constexpr int NSLOT=3, SLOTB=8192;
constexpr int LDS_K=0, LDS_V=NSLOT*SLOTB, LDS_WS=2*NSLOT*SLOTB, LDS_OST=LDS_WS+NW*64*4, LDS_BYTES=LDS_OST+NW*4096;
constexpr float C2=0.125f*1.4426950408889634f;
__device__ __forceinline__ void glds16(const void*gsrc,unsigned lds_dst){unsigned keep;
  asm volatile("s_mov_b32 %0, m0\n\ts_mov_b32 m0, %2\n\ts_nop 0\n\tglobal_load_lds_dwordx4 %1, off\n\ts_mov_b32 m0, %0":"=&s"(keep):"v"(gsrc),"s"(lds_dst):"memory");}
__device__ __forceinline__ float max3f(float a,float b,float c){float r;asm("v_max3_f32 %0, %1, %2, %3":"=v"(r):"v"(a),"v"(b),"v"(c));return r;}
__device__ __forceinline__ float max2f(float a,float b){float r;asm("v_max_f32_e32 %0, %1, %2":"=v"(r):"v"(a),"v"(b));return r;}
__device__ __forceinline__ float fadd_s(float a,float b){float r;asm("v_add_f32_e32 %0, %1, %2":"=v"(r):"v"(a),"v"(b));return r;}
__device__ __forceinline__ float fsub_s(float a,float b){float r;asm("v_sub_f32_e32 %0, %1, %2":"=v"(r):"v"(a),"v"(b));return r;}
typedef float f32x2_t __attribute__((ext_vector_type(2))); typedef __bf16 bf16x2_t __attribute__((ext_vector_type(2)));
__device__ __forceinline__ unsigned cvtpk_s(float lo,float hi){f32x2_t v={lo,hi};bf16x2_t b=__builtin_convertvector(v,bf16x2_t);return __builtin_bit_cast(unsigned,b);}
#define WAIT_BAR(N) asm volatile("s_waitcnt vmcnt(" #N ") lgkmcnt(0)\n\ts_barrier":::"memory")

__device__ __forceinline__ void qkt(f32x16&p0,f32x16&p1,const char*Kslot,const bf16x8*qr,const f32x16&negm,int r32,int hi){
  const char*kb=Kslot+hi*1024+r32*16;
  #pragma unroll
  for(int d0=0;d0<4;++d0){
    const bf16x8 b0=*reinterpret_cast<const bf16x8*>(kb+d0*2048);
    const bf16x8 b1=*reinterpret_cast<const bf16x8*>(kb+d0*2048+512);
    if(d0==0){p0=__builtin_amdgcn_mfma_f32_32x32x16_bf16(b0,qr[0],negm,0,0,0);p1=__builtin_amdgcn_mfma_f32_32x32x16_bf16(b1,qr[0],negm,0,0,0);}
    else{p0=__builtin_amdgcn_mfma_f32_32x32x16_bf16(b0,qr[d0],p0,0,0,0);p1=__builtin_amdgcn_mfma_f32_32x32x16_bf16(b1,qr[d0],p1,0,0,0);}}
}
typedef __attribute__((address_space(3))) const char* lds_cptr;
typedef short v4i16_t __attribute__((ext_vector_type(4)));
__device__ __forceinline__ void kload8(bf16x8*kf,lds_cptr kp){
  kf[0]=*(const __attribute__((address_space(3))) bf16x8*)(kp);      kf[1]=*(const __attribute__((address_space(3))) bf16x8*)(kp+512);
  kf[2]=*(const __attribute__((address_space(3))) bf16x8*)(kp+2048); kf[3]=*(const __attribute__((address_space(3))) bf16x8*)(kp+2560);
  kf[4]=*(const __attribute__((address_space(3))) bf16x8*)(kp+4096); kf[5]=*(const __attribute__((address_space(3))) bf16x8*)(kp+4608);
  kf[6]=*(const __attribute__((address_space(3))) bf16x8*)(kp+6144); kf[7]=*(const __attribute__((address_space(3))) bf16x8*)(kp+6656);
}
__device__ __forceinline__ void kload2(bf16x8*kf,lds_cptr kp,int j){ kf[2*j]=*(const __attribute__((address_space(3))) bf16x8*)(kp+j*2048); kf[2*j+1]=*(const __attribute__((address_space(3))) bf16x8*)(kp+j*2048+512); }
__device__ __forceinline__ s16x4 vtr(lds_cptr p){ return __builtin_bit_cast(s16x4,__builtin_amdgcn_ds_read_tr16_b64_v4i16((__attribute__((address_space(3))) v4i16_t*)p)); }
__device__ __forceinline__ float rowmax(const f32x16&p0,const f32x16&p1){
  float a=max3f(p0[0],p0[1],p1[0]),b=max3f(p0[2],p0[3],p1[1]);a=max3f(a,p1[2],p1[3]);
  #pragma unroll
  for(int r=4;r<16;r+=4){a=max3f(a,p0[r],p0[r+1]);b=max3f(b,p0[r+2],p0[r+3]);a=max3f(a,p1[r],p1[r+1]);b=max3f(b,p1[r+2],p1[r+3]);}
  const float m=max2f(a,b);
  auto rr=__builtin_amdgcn_permlane32_swap(__float_as_uint(m),__float_as_uint(m),false,false);
  return max2f(__uint_as_float(rr[0]),__uint_as_float(rr[1]));
}
__device__ __forceinline__ void pv(f32x16*o,int vb,bf16x8 pa0,bf16x8 pa1,bf16x8 pa2,bf16x8 pa3){
  #pragma unroll
  for(int d0=0;d0<2;++d0){s16x4 lo[4],hi[4];
    #pragma unroll
    for(int ks=0;ks<4;++ks){
      asm volatile("ds_read_b64_tr_b16 %0,%1 offset:%c2":"=&v"(lo[ks]):"v"(vb),"i"(d0*4096+ks*1024):"memory");
      asm volatile("ds_read_b64_tr_b16 %0,%1 offset:%c2":"=&v"(hi[ks]):"v"(vb),"i"(d0*4096+ks*1024+512):"memory");}
    asm volatile("s_waitcnt lgkmcnt(0)":::"memory");SBAR();
    #define PK(k) (bf16x8){lo[k][0],lo[k][1],lo[k][2],lo[k][3],hi[k][0],hi[k][1],hi[k][2],hi[k][3]}
    o[d0]=__builtin_amdgcn_mfma_f32_32x32x16_bf16(pa0,PK(0),o[d0],0,0,0);
    o[d0]=__builtin_amdgcn_mfma_f32_32x32x16_bf16(pa1,PK(1),o[d0],0,0,0);
    o[d0]=__builtin_amdgcn_mfma_f32_32x32x16_bf16(pa2,PK(2),o[d0],0,0,0);
    o[d0]=__builtin_amdgcn_mfma_f32_32x32x16_bf16(pa3,PK(3),o[d0],0,0,0);
    #undef PK
  }
}

#ifndef ATTN_STORE16
#define ATTN_STORE16(p,v) (*(u32x4*)(p)=(v))
#endif
template<int THRL> __device__ __forceinline__ void attn_unit(int b,int qcol,int vcol,int ocol,int qb,const bf16*Q,const bf16*__restrict__ K,const bf16*__restrict__ V,bf16*O,char*shm){
  int tid=threadIdx.x; asm volatile("":"+v"(tid));
  const int lane=tid&63,r32=lane&31,hi=lane>>5; const int wid=__builtin_amdgcn_readfirstlane(tid>>6);
  const long rowbase=(long)b*SEQ; const int q0=qb*QB;
  const bf16*Qw=Q+(rowbase+q0+wid*QBLK)*DM+qcol;
  const bf16*Kh=K+rowbase*DM+qcol,*Vh=V+rowbase*DM+vcol;
  const unsigned lds0=(unsigned)(uintptr_t)shm;
  float*wsf=(float*)(shm+LDS_WS)+wid*64;
  const bf16*ksrc=Kh+(long)lane*DM+wid*8;
  const bf16*vsrc=Vh+(long)(16*(wid&3)+(lane>>2))*DM+(wid>>2)*32+(lane&3)*8;
  const unsigned kdst=lds0+LDS_K+wid*1024, vdst=lds0+LDS_V+wid*1024;
  #define DMA_K(t,slot) glds16(ksrc+(long)(t)*KVBLK*DM,(unsigned)__builtin_amdgcn_readfirstlane(kdst+(slot)))
  #define DMA_V(t,slot) glds16(vsrc+(long)(t)*KVBLK*DM,(unsigned)__builtin_amdgcn_readfirstlane(vdst+(slot)))
  const int vb0=(int)(lds0+LDS_V)+((lane>>4)&1)*32+(lane&3)*8+(4*hi+((lane&15)>>2))*64;
  const char*Kbase=shm+LDS_K; bf16x8 kf[8];
  const lds_cptr shm3=(lds_cptr)shm; const lds_cptr kp0=shm3+LDS_K+hi*1024+r32*16; const lds_cptr vp0=shm3+LDS_V+((lane>>4)&1)*32+(lane&3)*8+(4*hi+((lane&15)>>2))*64;
  const int NT=(q0+QB)/KVBLK;
  DMA_K(0,0);DMA_V(0,0);DMA_K(1,SLOTB);
  bf16x8 qr[4];
  #pragma unroll
  for(int d0=0;d0<4;++d0)qr[d0]=*reinterpret_cast<const bf16x8*>(&Qw[(long)r32*DM+d0*16+hi*8]);
  float mhat=0.f,l_reg=0.f;f32x16 o[2];o[0]=f32x16{};o[1]=f32x16{};asm volatile("":"+v"(o[0]),"+v"(o[1]));f32x16 negm=f32x16{};asm volatile("":"+v"(negm));
  const int qrel=wid*QBLK+r32;
  #define CMASK(P0,P1,t) do{int jb_=(t)-(NT-4); if(jb_>=0)cmask(P0,P1,jb_,qrel,hi);}while(0)
  bool resc=false;
  #define START(P0,P1) do{ const float rm=rowmax(P0,P1); resc=false; \
    { const float dl=rm; mhat=fadd_s(mhat,dl); \
      _Pragma("unroll") for(int r=0;r<16;++r){P0[r]=fsub_s(P0[r],dl);P1[r]=fsub_s(P1[r],dl);} \
      _Pragma("unroll") for(int r=0;r<16;++r)negm[r]=-mhat; asm volatile("":"+v"(negm)); } \
    _Pragma("unroll") for(int r=0;r<16;++r)P0[r]=__builtin_amdgcn_exp2f(P0[r]); }while(0)
  #define RESC() do{ if(resc){ asm volatile("s_waitcnt lgkmcnt(0)":::"memory"); \
      _Pragma("unroll") for(int d_=0;d_<2;++d_) _Pragma("unroll") for(int r=0;r<16;++r)o[d_][r]*=wsf[crow(r,hi)]; } }while(0)
  f32x16 pA0,pA1,pB0,pB1;
  int sl_prev=0,sl_cur=0,sl_next=SLOTB;
  #define ROT() do{sl_prev=sl_cur;sl_cur=sl_next;sl_next=(sl_next==(NSLOT-1)*SLOTB)?0:sl_next+SLOTB;}while(0)
  DMA_K(2,2*SLOTB);
  WAIT_BAR(3);
  qkt(pA0,pA1,Kbase,qr,negm,r32,hi);asm volatile("s_nop 15\n\ts_nop 7":"+v"(pA0),"+v"(pA1));CMASK(pA0,pA1,0);
  START(pA0,pA1);
  _Pragma("unroll") for(int r=0;r<16;++r)pA1[r]=__builtin_amdgcn_exp2f(pA1[r]);
  WAIT_BAR(0);
  DMA_K(3,0);DMA_V(1,SLOTB);
  ROT();
  kload8(kf,kp0+sl_cur);
  WAIT_BAR(2);
  s16x4 vlo[8],vhi[8]; u32x4 pw0,pw1,pw2,pw3;
  #define PKW(P,B) cvtpk_s(P[B],P[B+1])
  #define PAF(k) __builtin_bit_cast(bf16x8,pw##k)
  #define VFR(i) (bf16x8){vlo[i][0],vlo[i][1],vlo[i][2],vlo[i][3],vhi[i][0],vhi[i][1],vhi[i][2],vhi[i][3]}
  #define PIN(x) asm volatile("":"+v"(x))
  #define MX3(a,b,c) __builtin_fmaxf(__builtin_fmaxf((a),(b)),(c))
  #define GAPA(MF,A0,A1,A2,A3,W0,W1,PW) do{ MF; sacc+=A0; sacc+=A1; sacc+=A2; sacc+=A3; PIN(sacc); W0; W1; PIN(PW); SBAR(); }while(0)
  #define EX(v) __builtin_amdgcn_exp2f(v)
  #define GAPB(MF,X,B) do{ MF; X[B]=EX(X[B]); X[B+1]=EX(X[B+1]); X[B+2]=EX(X[B+2]); X[B+3]=EX(X[B+3]); PIN(X); SBAR(); }while(0)
  #define VRD(i) do{ vlo[i]=vtr(vp_+(((i)>>2)*4096+((i)&3)*1024)); vhi[i]=vtr(vp_+(((i)>>2)*4096+((i)&3)*1024+512)); }while(0)
  #define KRD(G,j) do{ if(G){ kload2(kf,kp0+sl_next,j); SBAR(); } }while(0)
  #define STEP(C0,C1,P0,P1,t,GK,GV,GL) do{ SBAR(); \
    const lds_cptr vp_=vp0+sl_prev; \
    VRD(0); SBAR(); float sacc=(P0[0]+P0[1]); \
    GAPA(C0=__builtin_amdgcn_mfma_f32_32x32x16_bf16(kf[0],qr[0],negm,0,0,0), P0[2],P0[3],P0[4],P0[5],     pw0[0]=PKW(P0,0), pw0[1]=PKW(P0,2), pw0); \
    VRD(4); SBAR(); GAPA(C1=__builtin_amdgcn_mfma_f32_32x32x16_bf16(kf[1],qr[0],negm,0,0,0), P0[6],P0[7],P0[8],P0[9],     pw0[2]=PKW(P0,4), pw0[3]=PKW(P0,6), pw0); \
    VRD(1); SBAR(); GAPA(C0=__builtin_amdgcn_mfma_f32_32x32x16_bf16(kf[2],qr[1],C0,0,0,0),   P0[10],P0[11],P0[12],P0[13], pw1[0]=PKW(P0,8), pw1[1]=PKW(P0,10), pw1); \
    VRD(5); SBAR(); GAPA(C1=__builtin_amdgcn_mfma_f32_32x32x16_bf16(kf[3],qr[1],C1,0,0,0),   P0[14],P0[15],P1[0],P1[1],   pw1[2]=PKW(P0,12),pw1[3]=PKW(P0,14), pw1); \
    VRD(2); SBAR(); GAPA(C0=__builtin_amdgcn_mfma_f32_32x32x16_bf16(kf[4],qr[2],C0,0,0,0),   P1[2],P1[3],P1[4],P1[5],     pw2[0]=PKW(P1,0), pw2[1]=PKW(P1,2), pw2); \
    VRD(6); SBAR(); GAPA(C1=__builtin_amdgcn_mfma_f32_32x32x16_bf16(kf[5],qr[2],C1,0,0,0),   P1[6],P1[7],P1[8],P1[9],     pw2[2]=PKW(P1,4), pw2[3]=PKW(P1,6), pw2); \
    VRD(3); SBAR(); GAPA(C0=__builtin_amdgcn_mfma_f32_32x32x16_bf16(kf[6],qr[3],C0,0,0,0),   P1[10],P1[11],P1[12],P1[13], pw3[0]=PKW(P1,8), pw3[1]=PKW(P1,10), pw3); \
    VRD(7); SBAR(); GAPA(C1=__builtin_amdgcn_mfma_f32_32x32x16_bf16(kf[7],qr[3],C1,0,0,0),   P1[14],P1[15],0.f,0.f,       pw3[2]=PKW(P1,12),pw3[3]=PKW(P1,14), pw3); \
    l_reg+=sacc; \
    if(GK){DMA_K((t)+3,sl_cur);} if(GV){DMA_V((t)+1,sl_next);} \
    CMASK(C0,C1,t); \
    { float a=MX3(C0[0],C0[1],C1[0]),b=MX3(C0[2],C0[3],C1[1]); a=MX3(a,C1[2],C1[3]); \
      _Pragma("unroll") for(int r=4;r<16;r+=4){a=MX3(a,C0[r],C0[r+1]);b=MX3(b,C0[r+2],C0[r+3]);a=MX3(a,C1[r],C1[r+1]);b=MX3(b,C1[r+2],C1[r+3]);} \
      float rm=__builtin_fmaxf(a,b); { auto rr=__builtin_amdgcn_permlane32_swap(__float_as_uint(rm),__float_as_uint(rm),false,false); rm=__builtin_fmaxf(__uint_as_float(rr[0]),__uint_as_float(rr[1])); } \
      resc=false; \
      if(__builtin_expect(__any(rm>(float)THRL),0)){ const float dl=__builtin_fmaxf(rm,0.f); mhat+=dl; \
        _Pragma("unroll") for(int r=0;r<16;++r){C0[r]-=dl;C1[r]-=dl;} \
        _Pragma("unroll") for(int r=0;r<16;++r)negm[r]=-mhat; asm volatile("":"+v"(negm)); \
        const float f=__builtin_amdgcn_exp2f(-dl); l_reg*=f; if(hi==0)wsf[r32]=f; resc=true; } } \
    SBAR(); \
    GAPB(o[0]=__builtin_amdgcn_mfma_f32_32x32x16_bf16(PAF(0),VFR(0),o[0],0,0,0), C0,0); \
    GAPB(o[1]=__builtin_amdgcn_mfma_f32_32x32x16_bf16(PAF(0),VFR(4),o[1],0,0,0), C0,4); \
    KRD(GL,0); GAPB(o[0]=__builtin_amdgcn_mfma_f32_32x32x16_bf16(PAF(1),VFR(1),o[0],0,0,0), C0,8); \
    KRD(GL,1); GAPB(o[1]=__builtin_amdgcn_mfma_f32_32x32x16_bf16(PAF(1),VFR(5),o[1],0,0,0), C0,12); \
    KRD(GL,2); GAPB(o[0]=__builtin_amdgcn_mfma_f32_32x32x16_bf16(PAF(2),VFR(2),o[0],0,0,0), C1,0); \
    KRD(GL,3); GAPB(o[1]=__builtin_amdgcn_mfma_f32_32x32x16_bf16(PAF(2),VFR(6),o[1],0,0,0), C1,4); \
    GAPB(o[0]=__builtin_amdgcn_mfma_f32_32x32x16_bf16(PAF(3),VFR(3),o[0],0,0,0), C1,8); \
    GAPB(o[1]=__builtin_amdgcn_mfma_f32_32x32x16_bf16(PAF(3),VFR(7),o[1],0,0,0), C1,12); \
    }while(0)
  int t=1;
  #undef CMASK
  #define CMASK(P0,P1,t) do{}while(0)
  for(;t+5<NT;t+=2){
    STEP(pB0,pB1,pA0,pA1,t,true,true,true);     WAIT_BAR(2); RESC(); ROT();
    STEP(pA0,pA1,pB0,pB1,t+1,true,true,true);   WAIT_BAR(2); RESC(); ROT();
  }
  #undef CMASK
  #define CMASK(P0,P1,t) do{int jb_=(t)-(NT-4); if(jb_>=0)cmask(P0,P1,jb_,qrel,hi);}while(0)
  #define ENDW(tt) do{ if((tt)+3<NT){WAIT_BAR(2);} else if((tt)+2<NT){WAIT_BAR(1);} else {WAIT_BAR(0);} }while(0)
  for(;t+1<NT;t+=2){
    STEP(pB0,pB1,pA0,pA1,t,(t+3<NT),(t+1<NT),(t+1<NT));       ENDW(t);   RESC(); ROT();
    STEP(pA0,pA1,pB0,pB1,t+1,(t+4<NT),(t+2<NT),(t+2<NT));     ENDW(t+1); RESC(); ROT();
  }
  STEP(pB0,pB1,pA0,pA1,NT-1,false,false,false); RESC();
  { float sacc=pB0[0]+pB0[1]; _Pragma("unroll") for(int r=2;r<16;++r)sacc+=pB0[r]; _Pragma("unroll") for(int r=0;r<16;++r)sacc+=pB1[r]; l_reg+=sacc;
    pw0=(u32x4){PKW(pB0,0),PKW(pB0,2),PKW(pB0,4),PKW(pB0,6)};pw1=(u32x4){PKW(pB0,8),PKW(pB0,10),PKW(pB0,12),PKW(pB0,14)};pw2=(u32x4){PKW(pB1,0),PKW(pB1,2),PKW(pB1,4),PKW(pB1,6)};pw3=(u32x4){PKW(pB1,8),PKW(pB1,10),PKW(pB1,12),PKW(pB1,14)};
    SBAR(); pv(o,vb0+sl_cur,PAF(0),PAF(1),PAF(2),PAF(3)); }
  #undef PKW
  #undef PAF
  #undef VFR
  #undef PIN
  #undef MX3
  #undef GAPA
  #undef GAPB
  #undef EX
  #undef VRD
  #undef KRD
  #undef STEP
  #undef ENDW
  {auto rr=__builtin_amdgcn_permlane32_swap(__float_as_uint(l_reg),__float_as_uint(l_reg),false,false);l_reg=__uint_as_float(rr[0])+__uint_as_float(rr[1]);}
  if(hi==0)wsf[32+r32]=l_reg;asm volatile("s_waitcnt lgkmcnt(0)":::"memory");
  float rli[16];
  #pragma unroll
  for(int r=0;r<16;++r)rli[r]=__builtin_amdgcn_rcpf(wsf[32+crow(r,hi)]);
  bf16*Ow=O+(rowbase+q0+wid*QBLK)*OPITCH+ocol;
  { bf16*stg=(bf16*)(shm+LDS_OST)+wid*2048;
    #pragma unroll
    for(int r=0;r<16;++r){const int orow=crow(r,hi);
      #pragma unroll
      for(int d0=0;d0<2;++d0)stg[orow*64+d0*32+r32]=__float2bfloat16(o[d0][r]*rli[r]);}
    asm volatile("s_waitcnt lgkmcnt(0)":::"memory");
    int lane2=lane; asm volatile("":"+v"(lane2));
    #pragma unroll
    for(int i=0;i<4;++i){const int row=i*8+(lane2>>3),ch=lane2&7; const u32x4 v=*(const u32x4*)(stg+row*64+ch*8); ATTN_STORE16(Ow+(long)row*OPITCH+ch*8,v);} }
  asm volatile("s_waitcnt lgkmcnt(0)\n\ts_barrier":::"memory");
  #undef DMA_K
  #undef DMA_V
  #undef CMASK
  #undef START
  #undef RESC
  #undef ROT
}
constexpr int ATTN_LDS_BYTES=LDS_BYTES;
#undef SBAR
#undef WAIT_BAR
}

#define LAS __attribute__((address_space(3)))
typedef unsigned short bf16;
typedef unsigned v4u __attribute__((ext_vector_type(4)));
typedef float f32x4 __attribute__((ext_vector_type(4)));
typedef short bf16x8 __attribute__((ext_vector_type(8)));
#define LDS_WAIT() asm volatile("s_waitcnt lgkmcnt(0)" ::: "memory")
#define VM_WAIT() asm volatile("s_waitcnt vmcnt(0)" ::: "memory")

constexpr int NWAVES = 8, NTHR = 512, GRID = 256;
constexpr int BATCH = 4, SEQ = 4096, T = BATCH * SEQ, DM = 1024, NH = 8, FF = 4096, DIN = 8208;
constexpr int NCHUNK = SEQ / 64, NITEM = BATCH * NH * NCHUNK;
constexpr float EPS = 1e-6f;
constexpr float QSCALE = 0.125f * 1.4426950408889634f;
constexpr int NPHASE = 13;
#ifndef PH_MASK
#define PH_MASK 0x1fff
#endif
#ifndef MK_PER_PHASE
#define MK_PER_PHASE 0
#endif

constexpr size_t MiB = 1u << 20;
constexpr size_t WS_ROPE = 1 * MiB, WS_IFG = 2 * MiB, WS_SS1 = 3 * MiB, WS_SS2 = 3 * MiB + 256 * 1024, WS_CHK = 3 * MiB + 512 * 1024, WS_LAM = 3 * MiB + 768 * 1024;
constexpr size_t WS_NST = 4 * MiB, WS_WTIF = 5 * MiB;
constexpr size_t WS_WTIN = 6 * MiB, WS_WTAB = 22 * MiB, WS_WTOUT = 26 * MiB, WS_WTFF1 = 30 * MiB, WS_WTFF2 = 38 * MiB;
constexpr size_t WS_XN = 46 * MiB, WS_QA = 78 * MiB, WS_KA = 110 * MiB, WS_VA = 142 * MiB, WS_QKM = 174 * MiB, WS_VM = 206 * MiB, WS_END = 238 * MiB;
constexpr size_t WS_UST = WS_KA;
constexpr size_t WS_Y = WS_KA;
constexpr size_t WS_HB = WS_QKM;
constexpr size_t WS_U = WS_XN;

struct Params {
    const float* x; const int* pos; const float* norm_mix_w; const float* w_in; const float* gate_b; const float* conv_w; const float* conv_b; const float* da_lambda;
    const float* subln_w; const float* ml_norm_w; const float* w_a; const float* w_b; const float* w_out; const float* norm_ffn_w; const float* w_ff1; const float* w_ff2; const float* final_w;
    float* out; unsigned char* ws; int ph_lo, ph_hi;
};

__device__ __forceinline__ float bf_lo_(unsigned w) { return __uint_as_float(w << 16); }
__device__ __forceinline__ float bf_hi_(unsigned w) { return __uint_as_float(w & 0xffff0000u); }
__device__ __forceinline__ float bf2f(bf16 v) { return __uint_as_float((unsigned)v << 16); }
__device__ __forceinline__ unsigned f2bf(float f) { unsigned u = __builtin_bit_cast(unsigned, f); return (u + 0x7fffu + ((u >> 16) & 1u)) >> 16; }
__device__ __forceinline__ unsigned pk2(float lo, float hi) { return f2bf(lo) | (f2bf(hi) << 16); }
__device__ __forceinline__ float sigm_(float x) { return 1.f / (1.f + __expf(-x)); }
__device__ __forceinline__ float wave_sum(float v) {
#pragma unroll
    for (int o = 1; o < 64; o <<= 1) v += __shfl_xor(v, o);
    return v;
}
__device__ __forceinline__ float wave_max(float v) {
#pragma unroll
    for (int o = 1; o < 64; o <<= 1) v = fmaxf(v, __shfl_xor(v, o));
    return v;
}

#define GAS __attribute__((address_space(1)))
typedef GAS unsigned gu32;
#define RLX_AGENT __ATOMIC_RELAXED, __HIP_MEMORY_SCOPE_AGENT
constexpr int CW_BAR = 4096;
#define XB_TMO      128
#define XB_XCNT(j)  (256  + 64 * (j))
#define XB_XSUB(j)  (1280 + 64 * (j))
#define XB_XGEN(j)  (2304 + 64 * (j))
#define XB_TOP      3328
#define XB_TOPGEN   3392
#define XCD_BAR_WORDS 3456
#define XB_SPIN_CAP (1u << 18)

__device__ __forceinline__ unsigned xb_ld(unsigned* p)              { return __hip_atomic_load(p, __ATOMIC_RELAXED, __HIP_MEMORY_SCOPE_AGENT); }
__device__ __forceinline__ unsigned xb_add(unsigned* p, unsigned v) { return __hip_atomic_fetch_add(p, v, __ATOMIC_RELAXED, __HIP_MEMORY_SCOPE_AGENT); }
__device__ __forceinline__ unsigned xb_xcc_id() { return (unsigned)__builtin_amdgcn_s_getreg((3 << 11) | 20) & 0xFu; }
#define XB_SPIN(cond, bar) do { unsigned _sp = 0; while (cond) { __builtin_amdgcn_s_sleep(1); \
    if ((++_sp & 255u) == 0u) { if (xb_ld(&(bar)[XB_TMO])) break; if (_sp > XB_SPIN_CAP) { atomicAdd(&(bar)[XB_TMO], 1u); break; } } } } while (0)

struct XcdBarrier {
    unsigned* bar; unsigned x;
    volatile LAS unsigned* st;
};

__device__ __forceinline__ XcdBarrier xcd_barrier_post(unsigned* bar, volatile LAS unsigned* st) {
    XcdBarrier b; b.bar = bar; b.x = xb_xcc_id(); b.st = st;
    if (threadIdx.x == 0) (void)xb_add(&bar[XB_XCNT(b.x)], 1u);
    return b;
}
__device__ __forceinline__ void xcd_barrier_complete(unsigned* bar, unsigned x, unsigned& nloc, unsigned& nx) {
    const unsigned G = gridDim.x * gridDim.y * gridDim.z;
    unsigned sum, cnt, mine, sp = 0u;
    for (;;) {
        sum = 0u; cnt = 0u; mine = 0u;
#pragma unroll
        for (unsigned j = 0; j < 16; ++j) { const unsigned c = xb_ld(&bar[XB_XCNT(j)]); sum += c; cnt += (c > 0u) ? 1u : 0u; mine = (j == x) ? c : mine; }
        if (sum == G) break;
        __builtin_amdgcn_s_sleep(1);
        if ((++sp & 255u) == 0u) { if (xb_ld(&bar[XB_TMO])) break; if (sp > XB_SPIN_CAP) { atomicAdd(&bar[XB_TMO], 1u); break; } }
    }
    nloc = mine > 0u ? mine : 1u; nx = cnt > 0u ? cnt : 1u;
}

__device__ __forceinline__ void xcd_barrier(const XcdBarrier& b) {
    asm volatile("s_waitcnt vmcnt(0)" ::: "memory");
    __syncthreads();
    if (threadIdx.x == 0) {
        unsigned* bar = b.bar;
        __builtin_amdgcn_s_waitcnt(0);
        unsigned nloc = b.st[0], nx = b.st[1];
        if (nloc == 0u) { xcd_barrier_complete(bar, b.x, nloc, nx); b.st[0] = nloc; b.st[1] = nx; }
        const unsigned old = xb_add(&bar[XB_XSUB(b.x)], 1u);
        const unsigned gen = old / nloc;
        if (old + 1u == (gen + 1u) * nloc) {
            __builtin_amdgcn_fence(__ATOMIC_RELEASE, "agent");
            asm volatile("s_waitcnt vmcnt(0)" ::: "memory");
            const unsigned og = xb_add(&bar[XB_TOP], 1u);
            const unsigned tg = og / nx;
            if (og + 1u == (tg + 1u) * nx) xb_add(&bar[XB_TOPGEN], 1u);
            else XB_SPIN(xb_ld(&bar[XB_TOPGEN]) == tg, bar);
            __builtin_amdgcn_fence(__ATOMIC_ACQUIRE, "agent");
            xb_add(&bar[XB_XGEN(b.x)], 1u);
            asm volatile("s_waitcnt vmcnt(0)" ::: "memory");
        } else {
            XB_SPIN(xb_ld(&bar[XB_XGEN(b.x)]) == gen, bar);
            __builtin_amdgcn_fence(__ATOMIC_ACQUIRE, "agent");
            asm volatile("s_waitcnt vmcnt(0)" ::: "memory");
        }
    }
    __syncthreads();
}


__device__ __forceinline__ void p0_transpose_item(const float* W, int ldw, int k0, int n_src0, int nvalid, bf16* WT, int dst_row0, int ldt, int kdst_off,
                                                  const float* ks, int ksmask, float kmul, LAS float* scr, int lane) {
#pragma unroll 8
    for (int i = 0; i < 32; ++i) { const int kk = 2 * i + (lane >> 5), n = lane & 31;
        float v = (n < nvalid) ? W[(size_t)(k0 + kk) * ldw + n_src0 + n] : 0.f;
        if (ks) v *= ks[(k0 + kk) & ksmask] * kmul;
        scr[kk * 33 + n] = v; }
    LDS_WAIT(); asm volatile("" ::: "memory");
    const int c = lane & 7;
#pragma unroll
    for (int j = 0; j < 4; ++j) { const int n = (lane >> 3) + 8 * j; const LAS float* s = scr + (8 * c) * 33 + n;
        v4u o; o.x = pk2(s[0 * 33], s[1 * 33]); o.y = pk2(s[2 * 33], s[3 * 33]); o.z = pk2(s[4 * 33], s[5 * 33]); o.w = pk2(s[6 * 33], s[7 * 33]);
        if (n < nvalid) *(v4u*)(WT + (size_t)(dst_row0 + n) * ldt + kdst_off + k0 + 8 * c) = o; }
    LDS_WAIT(); asm volatile("" ::: "memory");
}
__device__ __forceinline__ void p0_prologue(const Params& p, LAS unsigned char* lds, int vcu) {
    int tid_ = threadIdx.x; asm volatile("" : "+v"(tid_)); const int lane = tid_ & 63, wave = __builtin_amdgcn_readfirstlane(tid_ >> 6);
    unsigned char* ws = p.ws;
    LAS float* scr = (LAS float*)(lds + wave * 16384);
    const int gw = vcu * NWAVES + wave, NGW = GRID * NWAVES;
    bf16* WTIN = (bf16*)(ws + WS_WTIN); bf16* WTIF = (bf16*)(ws + WS_WTIF); bf16* WTAB = (bf16*)(ws + WS_WTAB); bf16* WTOUT = (bf16*)(ws + WS_WTOUT);
    bf16* WTFF1 = (bf16*)(ws + WS_WTFF1); bf16* WTFF2 = (bf16*)(ws + WS_WTFF2);
    constexpr int I_IN = 16 * 256, I_IF = 16, I_A = 16 * 32, I_B = 16 * 32, I_O = 16 * 32 * 2, I_1 = 16 * 128, I_2 = 64 * 32;
    constexpr int NITEMS = I_IN + I_IF + I_A + I_B + I_O + I_1 + I_2;
    for (int it = gw; it < NITEMS; it += NGW) {
        int r = it;
        if (r < I_IN) { const int kb = r / 256, nb = r % 256, n0 = nb * 32; const int src = n0 + (n0 >= 5120 ? 16 : 0);
            p0_transpose_item(p.w_in, DIN, kb * 64, src, 32, WTIN, n0, 1024, 0, nullptr, 0, 1.f, scr, lane); continue; } r -= I_IN;
        if (r < I_IF) { p0_transpose_item(p.w_in, DIN, r * 64, 5120, 16, WTIF, 0, 1024, 0, nullptr, 0, 1.f, scr, lane); continue; } r -= I_IF;
        if (r < I_A) { const int kb = r / 32, nb = r % 32; p0_transpose_item(p.w_a, 1024, kb * 64, nb * 32, 32, WTAB, nb * 32, 1024, 0, p.subln_w, 127, 0.8f, scr, lane); continue; } r -= I_A;
        if (r < I_B) { const int kb = r / 32, nb = r % 32; p0_transpose_item(p.w_b, 1024, kb * 64, nb * 32, 32, WTAB, 1024 + nb * 32, 1024, 0, p.ml_norm_w, 1023, 1.f, scr, lane); continue; } r -= I_B;
        if (r < I_O) { const int half = r / 512, q = r % 512, kb = q / 32, nb = q % 32; p0_transpose_item(p.w_out, 1024, kb * 64, nb * 32, 32, WTOUT, nb * 32, 2048, half * 1024, nullptr, 0, 1.f, scr, lane); continue; } r -= I_O;
        if (r < I_1) { const int kb = r / 128, nb = r % 128; p0_transpose_item(p.w_ff1, FF, kb * 64, nb * 32, 32, WTFF1, nb * 32, 1024, 0, p.norm_ffn_w, 1023, 1.f, scr, lane); continue; } r -= I_1;
        { const int kb = r / 32, nb = r % 32; p0_transpose_item(p.w_ff2, 1024, kb * 64, nb * 32, 32, WTFF2, nb * 32, FF, 0, nullptr, 0, 1.f, scr, lane); }
    }
    bf16* XN = (bf16*)(ws + WS_XN);
    for (int m = gw; m < T; m += NGW) {
        const f32x4* xr = (const f32x4*)(p.x + (size_t)m * DM) + lane; const f32x4* wr_ = (const f32x4*)p.norm_mix_w + lane;
        f32x4 v[4]; float s = 0.f;
#pragma unroll
        for (int j = 0; j < 4; ++j) { v[j] = xr[64 * j]; s += (v[j].x * v[j].x + v[j].y * v[j].y) + (v[j].z * v[j].z + v[j].w * v[j].w); }
        const float rstd = 1.f / sqrtf(wave_sum(s) * (1.f / DM) + EPS);
        unsigned long long* o8 = (unsigned long long*)(XN + (size_t)m * DM) + lane;
#pragma unroll
        for (int j = 0; j < 4; ++j) { const f32x4 w = wr_[64 * j]; o8[64 * j] = (unsigned long long)pk2(v[j].x * rstd * w.x, v[j].y * rstd * w.y) | ((unsigned long long)pk2(v[j].z * rstd * w.z, v[j].w * rstd * w.w) << 32); }
    }
    { const int g = blockIdx.x * NTHR + tid_;
        float* rope = (float*)(ws + WS_ROPE);
        for (int e = g; e < T * 8; e += GRID * NTHR) { const int t = e >> 3, i = e & 7;
            const float inv = (float)exp(-(double)i * (1.0 / 8.0) * 13.122363377404328);
            const float ang = (float)p.pos[t] * inv;
            double rev = (double)ang * 0.15915494309189535; rev -= floor(rev);
            const float rv = (float)rev;
            rope[t * 16 + i] = __builtin_amdgcn_cosf(rv); rope[t * 16 + 8 + i] = __builtin_amdgcn_sinf(rv); } }
    if (blockIdx.x == 0 && wave == 0) { const float* L = p.da_lambda; const float a = wave_sum(L[lane] * L[64 + lane]), b = wave_sum(L[128 + lane] * L[192 + lane]);
        if (lane == 0) *(float*)(ws + WS_LAM) = expf(a) - expf(b) + 0.2f; }
}

__device__ __forceinline__ void p1_gates(const Params& p, int vcu) {
    int tid_ = threadIdx.x; asm volatile("" : "+v"(tid_)); const int lane = tid_ & 63, wave = __builtin_amdgcn_readfirstlane(tid_ >> 6);
    const bf16* XN = (const bf16*)(p.ws + WS_XN); const bf16* WTIF = (const bf16*)(p.ws + WS_WTIF); float* IFG = (float*)(p.ws + WS_IFG);
    const int gw = vcu * NWAVES + wave, NGW = GRID * NWAVES;
    for (int it = gw; it < T / 16; it += NGW) {
        const bf16* ap = XN + (size_t)(it * 16 + (lane & 15)) * DM + (lane >> 4) * 8; const bf16* bp = WTIF + (size_t)(lane & 15) * DM + (lane >> 4) * 8;
        f32x4 acc = {0.f, 0.f, 0.f, 0.f};
#pragma unroll 8
        for (int kk = 0; kk < 32; ++kk) { const bf16x8 a = *(const bf16x8*)(ap + kk * 32), b = *(const bf16x8*)(bp + kk * 32); acc = __builtin_amdgcn_mfma_f32_16x16x32_bf16(a, b, acc, 0, 0, 0); }
        const int n = lane & 15; const float gb = p.gate_b[n];
#pragma unroll
        for (int r = 0; r < 4; ++r) { const int tok = it * 16 + (lane >> 4) * 4 + r; float v = acc[r] + gb;
            if (n >= 8) v = fminf(v, 0.f) - log1pf(__expf(-fabsf(v)));
            IFG[(size_t)tok * 16 + n] = v; }
    }
}

__device__ __forceinline__ void attn_phase(const Params& p, char* lds, int vcu) {
    using abf = attn_body::bf16;
    {
        const abf* QA = (const abf*)(p.ws + WS_QA); const abf* KA = (const abf*)(p.ws + WS_KA); const abf* VA = (const abf*)(p.ws + WS_VA); abf* OATT = (abf*)p.out;
        const int bh = vcu >> 3, s = vcu & 7, b = bh >> 3, h = bh & 7;
#pragma unroll 1
        for (int su = 0; su < 8; ++su) {
            const int qb = (su < 4) ? 15 - s : s, c = (su >> 1) & 1, hf = su & 1;
            attn_body::attn_unit<8>(b, h * 128 + c * 64, h * 128 + hf * 64, h * 256 + c * 128 + hf * 64, qb, QA, KA, VA, OATT, lds);
        }
    }
    VM_WAIT(); __syncthreads();
    {
        int tid = threadIdx.x; asm volatile("" : "+v"(tid));
        const int bh = vcu >> 3, s = vcu & 7, b = bh >> 3, h = bh & 7;
        const float lam = *(const float*)(p.ws + WS_LAM);
        const bf16* O = (const bf16*)p.out; bf16* OAN = (bf16*)(p.ws + WS_QA);
#pragma unroll 1
        for (int ps = 0; ps < 8; ++ps) {
            const int qb = (ps < 4) ? 15 - s : s;
            const int r = (ps & 3) * 64 + (tid >> 3), v0 = (tid & 7) * 16; const size_t t = (size_t)b * SEQ + qb * 256 + r;
            const v4u* o0 = (const v4u*)(O + t * 2048 + h * 256 + v0); const v4u* o1 = (const v4u*)(O + t * 2048 + h * 256 + 128 + v0);
            float d[16]; float ss = 0.f;
#pragma unroll
            for (int j = 0; j < 2; ++j) { const v4u a = o0[j], bb = o1[j];
#pragma unroll
                for (int e = 0; e < 4; ++e) { const float lo = bf_lo_(a[e]) - lam * bf_lo_(bb[e]), hi = bf_hi_(a[e]) - lam * bf_hi_(bb[e]); d[j * 8 + 2 * e] = lo; d[j * 8 + 2 * e + 1] = hi; ss += lo * lo + hi * hi; } }
            ss += __shfl_xor(ss, 1); ss += __shfl_xor(ss, 2); ss += __shfl_xor(ss, 4);
            const float rstd = 1.f / sqrtf(ss * (1.f / 128.f) + EPS);
            v4u w0, w1;
#pragma unroll
            for (int e = 0; e < 4; ++e) { w0[e] = pk2(d[2 * e] * rstd, d[2 * e + 1] * rstd); w1[e] = pk2(d[8 + 2 * e] * rstd, d[8 + 2 * e + 1] * rstd); }
            v4u* dst = (v4u*)(OAN + t * 1024 + h * 128 + v0); dst[0] = w0; dst[1] = w1;
        }
    }
}

typedef short s16x4 __attribute__((ext_vector_type(4)));
typedef short v4i16_t __attribute__((ext_vector_type(4)));
typedef float f32x16 __attribute__((ext_vector_type(16)));
typedef float f32x2_t __attribute__((ext_vector_type(2))); typedef __bf16 bf16x2_t __attribute__((ext_vector_type(2)));
__device__ __forceinline__ unsigned cvtpk2(float lo, float hi) { f32x2_t v = {lo, hi}; bf16x2_t b = __builtin_convertvector(v, bf16x2_t); return __builtin_bit_cast(unsigned, b); }
__device__ __forceinline__ s16x4 ml_vtr(const LAS unsigned char* p) { return __builtin_bit_cast(s16x4, __builtin_amdgcn_ds_read_tr16_b64_v4i16((LAS v4i16_t*)p)); }
__device__ __forceinline__ bf16x8 ml_cat(s16x4 lo, s16x4 hi) { return (bf16x8){lo[0], lo[1], lo[2], lo[3], hi[0], hi[1], hi[2], hi[3]}; }
__device__ __forceinline__ int ml_crow(int reg, int h) { return (reg & 3) + 8 * (reg >> 2) + 4 * h; }
constexpr int ML_P64 = 144, ML_P128 = 288;
constexpr float LOG2E = 1.4426950408889634f;

__device__ __forceinline__ void ml_conv8(const Params& p, int b, int c, int s, int ch0, float scale, float (&o)[8]) {
    const bf16* QKM = (const bf16*)(p.ws + WS_QKM);
    { const f32x4 b0 = *(const f32x4*)(p.conv_b + ch0), b1 = *(const f32x4*)(p.conv_b + ch0 + 4); o[0] = b0.x; o[1] = b0.y; o[2] = b0.z; o[3] = b0.w; o[4] = b1.x; o[5] = b1.y; o[6] = b1.z; o[7] = b1.w; }
#pragma unroll
    for (int j = 0; j < 4; ++j) { const int tt = c * 64 + s - 3 + j;
        if (tt >= 0) { const v4u raw = *(const v4u*)(QKM + ((size_t)b * SEQ + tt) * 1024 + ch0); const f32x4 w0 = *(const f32x4*)(p.conv_w + j * 1024 + ch0), w1 = *(const f32x4*)(p.conv_w + j * 1024 + ch0 + 4);
            o[0] += w0.x * bf_lo_(raw.x); o[1] += w0.y * bf_hi_(raw.x); o[2] += w0.z * bf_lo_(raw.y); o[3] += w0.w * bf_hi_(raw.y);
            o[4] += w1.x * bf_lo_(raw.z); o[5] += w1.y * bf_hi_(raw.z); o[6] += w1.z * bf_lo_(raw.w); o[7] += w1.w * bf_hi_(raw.w); } }
#pragma unroll
    for (int e = 0; e < 8; ++e) o[e] = o[e] * scale * __builtin_amdgcn_rcpf(1.f + __builtin_amdgcn_exp2f(-LOG2E * o[e]));
}
__device__ __forceinline__ v4u ml_pack8(const float (&o)[8], float m) { v4u w; w.x = cvtpk2(o[0] * m, o[1] * m); w.y = cvtpk2(o[2] * m, o[3] * m); w.z = cvtpk2(o[4] * m, o[5] * m); w.w = cvtpk2(o[6] * m, o[7] * m); return w; }

__device__ __forceinline__ void mlstm_a(const Params& p, LAS unsigned char* lds, int vcu) {
    int tid = threadIdx.x; asm volatile("" : "+v"(tid));
    const int lane = tid & 63, wave = __builtin_amdgcn_readfirstlane(tid >> 6), r = lane & 31, h2 = lane >> 5, q4 = (lane & 15) >> 2, p4 = lane & 3, blk = (lane >> 4) & 1;
    LAS unsigned char* KS = lds; LAS unsigned char* VL = lds + 9216; LAS float* wsl = (LAS float*)(lds + 9216 + 18432);
    float* UST = (float*)(p.ws + WS_UST); float* NST = (float*)(p.ws + WS_NST); float* CHK = (float*)(p.ws + WS_CHK); const float* IFG = (const float*)(p.ws + WS_IFG);
    const bf16* VM = (const bf16*)(p.ws + WS_VM);
#pragma unroll 1
    for (int item = vcu * 8; item < vcu * 8 + 8; ++item) {
        const int bh = item >> 6, c = item & 63, b = bh >> 3, h = bh & 7; const size_t t0 = (size_t)b * SEQ + c * 64;
        if (wave == 0) { const float ig = IFG[(t0 + lane) * 16 + h], lf = IFG[(t0 + lane) * 16 + 8 + h]; float bs = lf;
#pragma unroll
            for (int o = 1; o < 64; o <<= 1) { const float t = __shfl_up(bs, o); if (lane >= o) bs += t; }
            const float bL = __shfl(bs, 63), wl = bL - bs + ig, mloc = wave_max(wl);
            wsl[lane] = __builtin_amdgcn_exp2f((wl - mloc) * LOG2E); if (lane == 0) { CHK[item * 4 + 0] = mloc; CHK[item * 4 + 1] = bL; } }
        __syncthreads();
        { const int s = tid >> 3, ch8 = (tid & 7) * 8; float o[8]; ml_conv8(p, b, c, s, 512 + h * 64 + ch8, 1.f, o);
            *(LAS v4u*)(KS + s * ML_P64 + ch8 * 2) = ml_pack8(o, wsl[s]); }
#pragma unroll
        for (int i = 0; i < 2; ++i) { const int pc = tid + i * NTHR, s = pc >> 4, v8 = (pc & 15) * 8;
            *(LAS v4u*)(VL + s * ML_P128 + v8 * 2) = *(const v4u*)(VM + (t0 + s) * 1024 + h * 128 + v8); }
        __syncthreads();
        const int vb = wave >> 1, db = wave & 1; f32x16 acc = {};
#pragma unroll
        for (int ks = 0; ks < 4; ++ks) {
            const LAS unsigned char* ap = VL + (16 * ks + 8 * h2 + q4) * ML_P128 + (32 * vb + 16 * blk) * 2 + 8 * p4;
            const LAS unsigned char* bp = KS + (16 * ks + 8 * h2 + q4) * ML_P64 + (32 * db + 16 * blk) * 2 + 8 * p4;
            const bf16x8 a = ml_cat(ml_vtr(ap), ml_vtr(ap + 4 * ML_P128)), bb = ml_cat(ml_vtr(bp), ml_vtr(bp + 4 * ML_P64));
            acc = __builtin_amdgcn_mfma_f32_32x32x16_bf16(a, bb, acc, 0, 0, 0); }
        float* up = UST + (size_t)item * 8192 + 32 * db + r;
#pragma unroll
        for (int i = 0; i < 16; ++i) up[(32 * vb + ml_crow(i, h2)) * 64] = acc[i];
        if (tid < 64) { float n = 0.f;
#pragma unroll 8
            for (int s = 0; s < 64; ++s) n += bf2f(*(const LAS bf16*)(KS + s * ML_P64 + tid * 2));
            NST[item * 64 + tid] = n; }
    }
}
__device__ __forceinline__ void mlstm_b(const Params& p) {
    const float* UST = (const float*)(p.ws + WS_UST); float* NST = (float*)(p.ws + WS_NST); float* CHK = (float*)(p.ws + WS_CHK); bf16* CT = (bf16*)p.out;
    constexpr int PER = 8192 + 64, TOTAL = BATCH * NH * PER;
    for (int e = blockIdx.x * NTHR + threadIdx.x; e < TOTAL; e += GRID * NTHR) {
        const int bh = e / PER, idx = e % PER; const bool isn = idx >= 8192;
        const float* src = isn ? NST + (size_t)bh * 64 * 64 + (idx - 8192) : UST + (size_t)bh * 64 * 8192 + idx; const int stride = isn ? 64 : 8192;
        bf16* dstb = CT + (size_t)bh * 64 * 8192 + idx; float* dstf = NST + (size_t)bh * 64 * 64 + (idx - 8192);
        float C = 0.f, m = 0.f;
#pragma unroll 4
        for (int c = 0; c < NCHUNK; ++c) { const int item = bh * 64 + c; const float mloc = CHK[item * 4 + 0], g = CHK[item * 4 + 1];
            const float u = src[(size_t)c * stride];
            if (isn) dstf[(size_t)c * 64] = C; else dstb[(size_t)c * 8192] = (bf16)f2bf(C);
            if (idx == 0) CHK[item * 4 + 2] = m;
            const float mn = fmaxf(g + m, mloc); C = __expf(g + m - mn) * C + __expf(mloc - mn) * u; m = mn; }
    }
}
__device__ __forceinline__ void mlstm_c(const Params& p, LAS unsigned char* lds, int vcu) {
    int tid = threadIdx.x; asm volatile("" : "+v"(tid));
    const int lane = tid & 63, wave = __builtin_amdgcn_readfirstlane(tid >> 6), r = lane & 31, h2 = lane >> 5, q4 = (lane & 15) >> 2, p4 = lane & 3, blk = (lane >> 4) & 1;
    LAS unsigned char* QL = lds; LAS unsigned char* KL = lds + 9216; LAS unsigned char* VL = lds + 18432; LAS unsigned char* CTL = lds + 36864; LAS unsigned char* OUTL = lds + 55296;
    LAS float* fa = (LAS float*)(lds + 72704); LAS float* bt2 = fa; LAS float* cs2 = fa + 64; LAS float* inl = fa + 128; LAS float* emt = fa + 192; LAS float* nl = fa + 256; LAS float* part = fa + 320;
    const float* NST = (const float*)(p.ws + WS_NST); const float* CHK = (const float*)(p.ws + WS_CHK); const float* IFG = (const float*)(p.ws + WS_IFG);
    const bf16* CT = (const bf16*)p.out; const bf16* VM = (const bf16*)(p.ws + WS_VM); bf16* OB = (bf16*)(p.ws + WS_VM);
#pragma unroll 1
    for (int item = vcu * 8; item < vcu * 8 + 8; ++item) {
        const int bh = item >> 6, c = item & 63, b = bh >> 3, h = bh & 7; const size_t t0 = (size_t)b * SEQ + c * 64;
        __syncthreads();
        if (wave == 7) { const float mc = CHK[item * 4 + 2]; const float ig = IFG[(t0 + lane) * 16 + h], lf = IFG[(t0 + lane) * 16 + 8 + h]; float bs = lf;
#pragma unroll
            for (int o = 1; o < 64; o <<= 1) { const float t = __shfl_up(bs, o); if (lane >= o) bs += t; }
            float pm = ig - bs;
#pragma unroll
            for (int o = 1; o < 64; o <<= 1) { const float t = __shfl_up(pm, o); if (lane >= o) pm = fmaxf(pm, t); }
            const float mt = bs + fmaxf(pm, mc);
            bt2[lane] = (bs - mt) * LOG2E; cs2[lane] = (ig - bs) * LOG2E; inl[lane] = __builtin_amdgcn_exp2f((bs + mc - mt) * LOG2E); emt[lane] = __builtin_amdgcn_exp2f(-mt * LOG2E); }
        { const int s = tid >> 3, ch8 = (tid & 7) * 8; float o[8];
            ml_conv8(p, b, c, s, h * 64 + ch8, 0.125f, o); *(LAS v4u*)(QL + s * ML_P64 + ch8 * 2) = ml_pack8(o, 1.f);
            ml_conv8(p, b, c, s, 512 + h * 64 + ch8, 1.f, o); *(LAS v4u*)(KL + s * ML_P64 + ch8 * 2) = ml_pack8(o, 1.f); }
#pragma unroll
        for (int i = 0; i < 2; ++i) { const int pc = tid + i * NTHR;
            { const int s = pc >> 4, v8 = (pc & 15) * 8; *(LAS v4u*)(VL + s * ML_P128 + v8 * 2) = *(const v4u*)(VM + (t0 + s) * 1024 + h * 128 + v8); }
            { const int v = pc >> 3, d8 = (pc & 7) * 8; *(LAS v4u*)(CTL + v * ML_P64 + d8 * 2) = *(const v4u*)(CT + (size_t)item * 8192 + v * 64 + d8); } }
        if (tid < 64) nl[tid] = NST[item * 64 + tid];
        __syncthreads();
        const int tb = wave & 1, vb = wave >> 1, t = 32 * tb + r;
        bf16x8 qf[4];
#pragma unroll
        for (int ks = 0; ks < 4; ++ks) qf[ks] = *(const LAS bf16x8*)(QL + t * ML_P64 + (16 * ks + 8 * h2) * 2);
        f32x16 X[2]; X[0] = (f32x16){}; X[1] = (f32x16){};
#pragma unroll
        for (int sb = 0; sb < 2; ++sb)
#pragma unroll
            for (int ks = 0; ks < 4; ++ks) { const bf16x8 kf = *(const LAS bf16x8*)(KL + (32 * sb + r) * ML_P64 + (16 * ks + 8 * h2) * 2);
                X[sb] = __builtin_amdgcn_mfma_f32_32x32x16_bf16(kf, qf[ks], X[sb], 0, 0, 0); }
        const float btl = bt2[t]; float dsum = 0.f;
#pragma unroll
        for (int sb = 0; sb < 2; ++sb)
#pragma unroll
            for (int g = 0; g < 4; ++g) { const f32x4 cs4 = *(const LAS f32x4*)(cs2 + 32 * sb + 8 * g + 4 * h2);
#pragma unroll
                for (int e = 0; e < 4; ++e) { const int s = 32 * sb + 8 * g + 4 * h2 + e; const float w = (s <= t) ? __builtin_amdgcn_exp2f(btl + cs4[e]) : 0.f;
                    const float x = X[sb][4 * g + e] * w; X[sb][4 * g + e] = x; dsum += x; } }
        dsum += __shfl_xor(dsum, 32);
        float qn = 0.f;
#pragma unroll
        for (int ks = 0; ks < 4; ++ks) { const f32x4 n0 = *(const LAS f32x4*)(nl + 16 * ks + 8 * h2), n1 = *(const LAS f32x4*)(nl + 16 * ks + 8 * h2 + 4); const bf16x8 q = qf[ks];
            qn += bf2f((bf16)q[0]) * n0.x + bf2f((bf16)q[1]) * n0.y + bf2f((bf16)q[2]) * n0.z + bf2f((bf16)q[3]) * n0.w + bf2f((bf16)q[4]) * n1.x + bf2f((bf16)q[5]) * n1.y + bf2f((bf16)q[6]) * n1.z + bf2f((bf16)q[7]) * n1.w; }
        qn += __shfl_xor(qn, 32);
        f32x16 acc1 = {}, acc2 = {};
#pragma unroll
        for (int sb = 0; sb < 2; ++sb)
#pragma unroll
            for (int sp = 0; sp < 2; ++sp) {
                const LAS unsigned char* ap = VL + (32 * sb + 16 * sp + 4 * h2 + q4) * ML_P128 + (32 * vb + 16 * blk) * 2 + 8 * p4;
                const bf16x8 a = ml_cat(ml_vtr(ap), ml_vtr(ap + 8 * ML_P128));
                v4u pk; pk.x = cvtpk2(X[sb][8 * sp + 0], X[sb][8 * sp + 1]); pk.y = cvtpk2(X[sb][8 * sp + 2], X[sb][8 * sp + 3]); pk.z = cvtpk2(X[sb][8 * sp + 4], X[sb][8 * sp + 5]); pk.w = cvtpk2(X[sb][8 * sp + 6], X[sb][8 * sp + 7]);
                acc1 = __builtin_amdgcn_mfma_f32_32x32x16_bf16(a, __builtin_bit_cast(bf16x8, pk), acc1, 0, 0, 0); }
#pragma unroll
        for (int ks = 0; ks < 4; ++ks) { const bf16x8 a = *(const LAS bf16x8*)(CTL + (32 * vb + r) * ML_P64 + (16 * ks + 8 * h2) * 2);
            acc2 = __builtin_amdgcn_mfma_f32_32x32x16_bf16(a, qf[ks], acc2, 0, 0, 0); }
        const float inter = inl[t], den = dsum + inter * qn, rden = 1.f / fmaxf(fabsf(den), emt[t]);
        float ss = 0.f;
#pragma unroll
        for (int i = 0; i < 16; ++i) { const float x = (acc1[i] + inter * acc2[i]) * rden; acc1[i] = x; ss += x * x; }
        ss += __shfl_xor(ss, 32);
        if (h2 == 0) part[vb * 64 + t] = ss;
        __syncthreads();
        const float rstd = 1.f / sqrtf(((part[t] + part[64 + t]) + (part[128 + t] + part[192 + t])) * (1.f / 128.f) + EPS);
#pragma unroll
        for (int g = 0; g < 4; ++g) { typedef unsigned u32x2v __attribute__((ext_vector_type(2))); u32x2v w; w.x = cvtpk2(acc1[4 * g] * rstd, acc1[4 * g + 1] * rstd); w.y = cvtpk2(acc1[4 * g + 2] * rstd, acc1[4 * g + 3] * rstd);
            *(LAS u32x2v*)(OUTL + t * 272 + (32 * vb + 8 * g + 4 * h2) * 2) = w; }
        __syncthreads();
#pragma unroll
        for (int i = 0; i < 2; ++i) { const int pc = tid + i * NTHR, tr = pc >> 4, v8 = (pc & 15) * 8;
            *(v4u*)(OB + (t0 + tr) * 1024 + h * 128 + v8) = *(const LAS v4u*)(OUTL + tr * 272 + v8 * 2); }
    }
}

__device__ __forceinline__ void final_norm(const Params& p, int vcu) {
    int tid_ = threadIdx.x; asm volatile("" : "+v"(tid_)); const int lane = tid_ & 63, wave = __builtin_amdgcn_readfirstlane(tid_ >> 6);
    const float* SS2 = (const float*)(p.ws + WS_SS2); const int gw = vcu * NWAVES + wave, NGW = GRID * NWAVES;
    for (int m = gw; m < T; m += NGW) {
        const f32x4 q = *(const f32x4*)(SS2 + (size_t)m * 4); const float rstd = 1.f / sqrtf(((q.x + q.y) + (q.z + q.w)) * (1.f / DM) + EPS);
        f32x4* xr = (f32x4*)(p.out + (size_t)m * DM) + lane; const f32x4* wr_ = (const f32x4*)p.final_w + lane;
#pragma unroll
        for (int j = 0; j < 4; ++j) { const f32x4 v = xr[64 * j], w = wr_[64 * j]; xr[64 * j] = v * rstd * w; }
    }
}

constexpr int LDS_BYTES = 147456;
__global__ void __launch_bounds__(NTHR, 2) mk_fwd(Params p) {
    extern __shared__ __attribute__((aligned(16))) unsigned char lds_raw[];
    LAS unsigned char* lds = (LAS unsigned char*)lds_raw;
    const int tid = threadIdx.x;
    const int bx = blockIdx.x, vcu = (bx % 8) * (GRID / 8) + bx / 8;
    unsigned char* ws = p.ws;
    bf16* XN = (bf16*)(ws + WS_XN); bf16* WTIN = (bf16*)(ws + WS_WTIN);
    const int lo = p.ph_lo, hi = p.ph_hi;
    volatile LAS unsigned* MISC = (volatile LAS unsigned*)(lds + LDS_BYTES - 64);
    if (tid < 16) MISC[tid] = 0u;
    __syncthreads();
    XcdBarrier bar; bar.bar = (unsigned*)(ws) + CW_BAR; bar.x = 0; bar.st = nullptr;
    if (hi - lo > 1) bar = xcd_barrier_post((unsigned*)(ws) + CW_BAR, MISC);
#define IN(k) (lo <= (k) && (k) < hi)
#define SEAM(k) do { if (IN(k) && IN((k) + 1)) xcd_barrier(bar); } while (0)
#if (PH_MASK >> 0) & 1
        if (IN(0)) { p0_prologue(p, lds, vcu); } SEAM(0);
#endif
#if (PH_MASK >> 1) & 1
        if (IN(1)) { {
            pg8::Gemm g{XN, WTIN, T, 5120, DM, nullptr, 1 << 30}; pg8::StaticOrder S; S.init(T, 5120, GRID, bx);
            pg8::EpiInProj E{(bf16*)(ws + WS_QA), (size_t)T * 1024, (const float*)(ws + WS_ROPE), QSCALE};
            pg8::gemm_phase<pg8::EpiInProj, pg8::StaticOrder, true, true>(lds, g, S, E);
            p1_gates(p, vcu);
        } } SEAM(1);
#endif
#if (PH_MASK >> 2) & 1
        if (IN(2)) { attn_phase(p, (char*)lds_raw, vcu); } SEAM(2);
#endif
#if (PH_MASK >> 3) & 1
        if (IN(3)) { mlstm_a(p, lds, vcu); } SEAM(3);
#endif
#if (PH_MASK >> 4) & 1
        if (IN(4)) { mlstm_b(p); } SEAM(4);
#endif
#if (PH_MASK >> 5) & 1
        if (IN(5)) { mlstm_c(p, lds, vcu); } SEAM(5);
#endif
#if (PH_MASK >> 6) & 1
        if (IN(6)) { {
            pg8::Gemm g{XN, WTIN + (size_t)5120 * 1024, T, 1024, DM, nullptr, 1 << 30}; pg8::StaticOrder S; S.init(T, 1024, GRID, bx);
            pg8::EpiSigMul E{(bf16*)(ws + WS_VM), 1024};
            pg8::gemm_phase<pg8::EpiSigMul, pg8::StaticOrder, true, true>(lds, g, S, E);
        } } SEAM(6);
#endif
#if (PH_MASK >> 7) & 1
        if (IN(7)) { {
            pg8::Gemm g{(const bf16*)(ws + WS_QA), (const bf16*)(ws + WS_WTAB), T, 2048, DM, (const bf16*)(ws + WS_VM), 4}; pg8::StaticOrder S; S.init(T, 2048, GRID, bx);
            pg8::EpiBf16<0> E{(bf16*)(ws + WS_Y), 2048, nullptr, 0, 0, 1.f};
            pg8::gemm_phase<pg8::EpiBf16<0>, pg8::StaticOrder, true, true>(lds, g, S, E);
        } } SEAM(7);
#endif
#if (PH_MASK >> 8) & 1
        if (IN(8)) { {
            pg8::Gemm g{XN, WTIN + (size_t)6144 * 1024, T, 2048, DM, nullptr, 1 << 30}; pg8::StaticOrder S; S.init(T, 2048, GRID, bx);
            pg8::EpiSigMul E{(bf16*)(ws + WS_Y), 2048};
            pg8::gemm_phase<pg8::EpiSigMul, pg8::StaticOrder, true, true>(lds, g, S, E);
        } } SEAM(8);
#endif
#if (PH_MASK >> 9) & 1
        if (IN(9)) { {
            pg8::Gemm g{(const bf16*)(ws + WS_Y), (const bf16*)(ws + WS_WTOUT), T, 1024, 2048, nullptr, 1 << 30}; pg8::StaticOrder S; S.init(T, 1024, GRID, bx);
            pg8::EpiRes E{p.x, p.out, (bf16*)(ws + WS_HB), (float*)(ws + WS_SS1)};
            pg8::gemm_phase<pg8::EpiRes, pg8::StaticOrder, false, true>(lds, g, S, E);
        } } SEAM(9);
#endif
#if (PH_MASK >> 10) & 1
        if (IN(10)) { {
            pg8::Gemm g{(const bf16*)(ws + WS_HB), (const bf16*)(ws + WS_WTFF1), T, FF, DM, nullptr, 1 << 30}; pg8::StaticOrder S; S.init(T, FF, GRID, bx);
            pg8::EpiFF1 E{(bf16*)(ws + WS_U), FF, (const float*)(ws + WS_SS1), EPS};
            pg8::gemm_phase<pg8::EpiFF1, pg8::StaticOrder, true, true>(lds, g, S, E);
        } } SEAM(10);
#endif
#if (PH_MASK >> 11) & 1
        if (IN(11)) { {
            pg8::Gemm g{(const bf16*)(ws + WS_U), (const bf16*)(ws + WS_WTFF2), T, 1024, FF, nullptr, 1 << 30}; pg8::StaticOrder S; S.init(T, 1024, GRID, bx);
            pg8::EpiRes E{p.out, p.out, nullptr, (float*)(ws + WS_SS2)};
            pg8::gemm_phase<pg8::EpiRes, pg8::StaticOrder, false, true>(lds, g, S, E);
        } } SEAM(11);
#endif
#if (PH_MASK >> 12) & 1
        if (IN(12)) { final_norm(p, vcu); } SEAM(12);
#endif
#undef IN
#undef SEAM
}

extern "C" void kernel_launch(void* const* d_in, const int* in_sizes, int n_in, void* d_out, int out_size, void* d_ws, size_t ws_size, hipStream_t stream) {
    static int ready = 0;
    if (!ready) {
        if (n_in != 17 || in_sizes[0] != T * DM || out_size != T * DM || ws_size < WS_END) { fprintf(stderr, "kernel_launch: unexpected shapes (n_in %d in0 %d out %d ws %zu)\n", n_in, n_in > 0 ? in_sizes[0] : -1, out_size, ws_size); ready = -1; return; }
        if (hipFuncSetAttribute((const void*)mk_fwd, hipFuncAttributeMaxDynamicSharedMemorySize, LDS_BYTES) != hipSuccess) { fprintf(stderr, "kernel_launch: hipFuncSetAttribute failed\n"); ready = -1; return; }
        int per_cu = 0; (void)hipOccupancyMaxActiveBlocksPerMultiprocessor(&per_cu, (const void*)mk_fwd, NTHR, LDS_BYTES); (void)hipGetLastError();
        int dev = 0, cus = 0; (void)hipGetDevice(&dev); (void)hipDeviceGetAttribute(&cus, hipDeviceAttributeMultiprocessorCount, dev);
        if (per_cu < 1 || cus < GRID) fprintf(stderr, "kernel_launch: note: occupancy %d blocks/CU, %d CUs (need 1 x %d)\n", per_cu, cus, GRID);
        ready = 1;
    }
    if (ready < 0) return;
    Params p{};
    p.x = (const float*)d_in[0]; p.pos = (const int*)d_in[1]; p.norm_mix_w = (const float*)d_in[2]; p.w_in = (const float*)d_in[3]; p.gate_b = (const float*)d_in[4];
    p.conv_w = (const float*)d_in[5]; p.conv_b = (const float*)d_in[6]; p.da_lambda = (const float*)d_in[7]; p.subln_w = (const float*)d_in[8]; p.ml_norm_w = (const float*)d_in[9];
    p.w_a = (const float*)d_in[10]; p.w_b = (const float*)d_in[11]; p.w_out = (const float*)d_in[12]; p.norm_ffn_w = (const float*)d_in[13]; p.w_ff1 = (const float*)d_in[14];
    p.w_ff2 = (const float*)d_in[15]; p.final_w = (const float*)d_in[16]; p.out = (float*)d_out; p.ws = (unsigned char*)d_ws;
#if MK_PER_PHASE
    for (int ph = 0; ph < NPHASE; ++ph) { p.ph_lo = ph; p.ph_hi = ph + 1; hipLaunchKernelGGL(mk_fwd, dim3(GRID), dim3(NTHR), LDS_BYTES, stream, p); }
#else
    if (hipMemsetAsync(d_ws, 0, 1 * MiB, stream) != hipSuccess) { fprintf(stderr, "kernel_launch: memset of the control words failed\n"); return; }
    p.ph_lo = 0; p.ph_hi = NPHASE; void* args[] = {&p};
    hipError_t e = hipLaunchCooperativeKernel((const void*)mk_fwd, dim3(GRID), dim3(NTHR), args, LDS_BYTES, stream);
    if (e != hipSuccess) fprintf(stderr, "cooperative launch failed: %s\n", hipGetErrorString(e));
#endif
}
```

```cpp
#include <hip/hip_runtime.h>
#include <cstdio>
#include <cstdint>
namespace pg8 {
#define PG8_LAS __attribute__((address_space(3)))
typedef unsigned short bf16_t;
typedef short bf16x8 __attribute__((ext_vector_type(8)));
typedef float f32x4 __attribute__((ext_vector_type(4)));
typedef unsigned u32x4 __attribute__((ext_vector_type(4)));
constexpr int BM = 256, BK = 64, HALF = 128, HTB = HALF * BK * 2  , STAGE_BYTES = 8 * HTB, NXCD = 8, WGM = 8;

__host__ __device__ __forceinline__ int lds_byte(int r, int c) { const int st = (r >> 4) * 2 + (c >> 5), rr = r & 15, cc = c & 31, ob = rr * 64 + cc * 2; return st * 1024 + (ob ^ (((ob >> 9) & 1) << 5)); }
__host__ __device__ __forceinline__ void stage_rc(int b, int& R, int& C) { const int st = b / 1024, sb = b % 1024, swz = sb ^ (((sb >> 9) & 1) << 5); R = (st >> 1) * 16 + swz / 64; C = (st & 1) * 32 + (swz % 64) / 2; }
__host__ __device__ __forceinline__ int perm32(int rho) { const int n = rho >> 4, i = rho & 15; return 8 * (i >> 2) + 4 * n + (i & 3); }

struct Unit { int pm, pn; };
struct Gemm { const bf16_t* A; const bf16_t* Bt; int M, N, K; const bf16_t* A2; int pn_split; };

struct StaticOrder {
    int nM, nN, nwg, G, c;
    __host__ __device__ void init(int M, int N, int G_, int c_) { nM = M / BM; nN = N / BM; nwg = nM * nN; G = G_; c = c_; }
    __host__ __device__ bool next(int i, Unit& u) const {
        const long L = (long)i * G + c; if (L >= nwg) return false;
        int wgid = (int)L; { const int q = nwg / NXCD, r = nwg % NXCD, xcd = wgid % NXCD, off = wgid / NXCD; wgid = (xcd < r ? xcd * (q + 1) : r * (q + 1) + (xcd - r) * q) + off; }
        const int nig = WGM * nN, gid = wgid / nig, fm = gid * WGM, gsz = (nM - fm) < WGM ? (nM - fm) : WGM;
        u.pm = fm + ((wgid % nig) % gsz); u.pn = (wgid % nig) / gsz; return true;
    }
    __device__ __forceinline__ void a_ready(const Unit&) const {}
    __device__ __forceinline__ void done(const Unit&) const {}
};

__device__ __forceinline__ unsigned cvt_pk_bf16(float lo, float hi) { unsigned r; asm volatile("v_cvt_pk_bf16_f32 %0, %1, %2" : "=v"(r) : "v"(lo), "v"(hi)); return r; }
typedef float f32x2 __attribute__((ext_vector_type(2)));
__device__ __forceinline__ f32x2 gelu_pk(f32x2 v) {
    const f32x2 av = __builtin_elementwise_abs(v), d = av * 0.2316418882f + 1.0f;
    f32x2 t; t.x = __builtin_amdgcn_rcpf(d.x); t.y = __builtin_amdgcn_rcpf(d.y);
    f32x2 q = t * 0.5307027145f + (-0.7265760135f); q = q * t + 0.7107068705f; q = q * t + (-0.142248368f); q = q * t + 0.127414796f; q = q * t;
    const f32x2 s = (v * v) * (-0.72134752044f);
    f32x2 e; e.x = __builtin_amdgcn_exp2f(s.x); e.y = __builtin_amdgcn_exp2f(s.y);
    const f32x2 m = v * (q * e), r = v - m;
    f32x2 o; o.x = v.x < 0.f ? m.x : r.x; o.y = v.y < 0.f ? m.y : r.y; return o;
}

template <int ACT  > struct EpiBf16 {
    static constexpr bool PERM = true, AFTER_DRAIN = false; static_assert(ACT == 0 || ACT == 1, "EpiBf16: ACT is 0 (none) or 1 (gelu_pk)");
    bf16_t* O; int ldc; const float* bias; int split_cols; size_t split_stride; float scale0;
    __device__ __forceinline__ void operator()(const f32x4 (&acc)[2][2][4][2], const Unit& u, int wr, int wc, int fr, int fq) const {
        const int row0 = u.pm * BM + wr * 64 + fr; int colt = u.pn * BM; bf16_t* base = O;
        float sc = 1.f; if (split_cols) { const int t = colt / split_cols; base += (size_t)t * split_stride; colt -= t * split_cols; if (t == 0) sc = scale0; }
        const int col0 = colt + wc * 32 + 8 * fq, bcol0 = u.pn * BM + wc * 32 + 8 * fq;
        f32x4 bv[2][2];
#pragma unroll
        for (int bj = 0; bj < 2; ++bj)
#pragma unroll
            for (int n = 0; n < 2; ++n) bv[bj][n] = bias ? *(const f32x4*)(bias + bcol0 + bj * HALF + 4 * n) : (f32x4){0.f, 0.f, 0.f, 0.f};
#pragma unroll
        for (int ai = 0; ai < 2; ++ai)
#pragma unroll
            for (int m = 0; m < 4; ++m) { bf16_t* rowp = base + (size_t)(row0 + ai * HALF + m * 16) * ldc + col0;
#pragma unroll
                for (int bj = 0; bj < 2; ++bj) { f32x4 v0 = acc[ai][bj][m][0] + bv[bj][0], v1 = acc[ai][bj][m][1] + bv[bj][1];
                    if (ACT == 1) { f32x2 a = gelu_pk((f32x2){v0[0], v0[1]}), b = gelu_pk((f32x2){v0[2], v0[3]}), c = gelu_pk((f32x2){v1[0], v1[1]}), d = gelu_pk((f32x2){v1[2], v1[3]});
                        v0 = (f32x4){a.x, a.y, b.x, b.y}; v1 = (f32x4){c.x, c.y, d.x, d.y}; }
                    v0 = v0 * sc; v1 = v1 * sc; u32x4 w; w.x = cvt_pk_bf16(v0[0], v0[1]); w.y = cvt_pk_bf16(v0[2], v0[3]); w.z = cvt_pk_bf16(v1[0], v1[1]); w.w = cvt_pk_bf16(v1[2], v1[3]);
                    *(u32x4*)(rowp + bj * HALF) = w; } }
    }
};


__device__ __forceinline__ float sigm(float x) { return __builtin_amdgcn_rcpf(1.f + __builtin_amdgcn_exp2f(-1.4426950408889634f * x)); }
__device__ __forceinline__ float bf_lo(unsigned w) { return __uint_as_float(w << 16); }
__device__ __forceinline__ float bf_hi(unsigned w) { return __uint_as_float(w & 0xffff0000u); }

struct EpiInProj {
    static constexpr bool PERM = true, AFTER_DRAIN = false;
    bf16_t* base0; size_t bufstride; const float* rope; float qscale;
    __device__ __forceinline__ void operator()(const f32x4 (&acc)[2][2][4][2], const Unit& u, int wr, int wc, int fr, int fq) const {
        const int buf = u.pn >> 2; bf16_t* base = base0 + (size_t)buf * bufstride;
        const int row0 = u.pm * BM + wr * 64 + fr, col0 = (u.pn & 3) * 256 + wc * 32 + 8 * fq;
        const bool ropew = (buf < 2) && ((wc & 1) == 0);
        const float sc = (buf == 0) ? qscale : 1.f;
#pragma unroll
        for (int ai = 0; ai < 2; ++ai)
#pragma unroll
            for (int m = 0; m < 4; ++m) {
                const int row = row0 + ai * HALF + m * 16; bf16_t* rowp = base + (size_t)row * 1024 + col0;
                f32x4 c0 = {1.f, 1.f, 1.f, 1.f}, c1 = c0, s0 = {0.f, 0.f, 0.f, 0.f}, s1 = s0;
                if (ropew) { const f32x4* rp = (const f32x4*)(rope + (size_t)row * 16); c0 = rp[0]; c1 = rp[1]; s0 = rp[2]; s1 = rp[3]; }
#pragma unroll
                for (int bj = 0; bj < 2; ++bj) {
                    f32x4 v0 = acc[ai][bj][m][0], v1 = acc[ai][bj][m][1];
                    if (ropew) {
                        f32x4 p0, p1;
#pragma unroll
                        for (int e = 0; e < 4; ++e) { p0[e] = __shfl_xor(v0[e], 16); p1[e] = __shfl_xor(v1[e], 16); }
                        if (fq == 0) { v0 = v0 * c0 - p0 * s0; v1 = v1 * c1 - p1 * s1; }
                        else if (fq == 1) { v0 = v0 * c0 + p0 * s0; v1 = v1 * c1 + p1 * s1; }
                    }
                    v0 = v0 * sc; v1 = v1 * sc;
                    u32x4 w; w.x = cvt_pk_bf16(v0[0], v0[1]); w.y = cvt_pk_bf16(v0[2], v0[3]); w.z = cvt_pk_bf16(v1[0], v1[1]); w.w = cvt_pk_bf16(v1[2], v1[3]);
                    *(u32x4*)(rowp + bj * HALF) = w;
                }
            }
    }
};
struct EpiSigMul {
    static constexpr bool PERM = true, AFTER_DRAIN = false;
    bf16_t* O; int ldc;
    __device__ __forceinline__ void operator()(const f32x4 (&acc)[2][2][4][2], const Unit& u, int wr, int wc, int fr, int fq) const {
        const int row0 = u.pm * BM + wr * 64 + fr, col0 = u.pn * BM + wc * 32 + 8 * fq;
#pragma unroll
        for (int ai = 0; ai < 2; ++ai)
#pragma unroll
            for (int m = 0; m < 4; ++m) {
                bf16_t* rowp = O + (size_t)(row0 + ai * HALF + m * 16) * ldc + col0;
#pragma unroll
                for (int bj = 0; bj < 2; ++bj) {
                    const u32x4 old = *(const u32x4*)(rowp + bj * HALF);
                    const f32x4 v0 = acc[ai][bj][m][0], v1 = acc[ai][bj][m][1];
                    u32x4 w;
                    w.x = cvt_pk_bf16(sigm(v0[0]) * bf_lo(old.x), sigm(v0[1]) * bf_hi(old.x));
                    w.y = cvt_pk_bf16(sigm(v0[2]) * bf_lo(old.y), sigm(v0[3]) * bf_hi(old.y));
                    w.z = cvt_pk_bf16(sigm(v1[0]) * bf_lo(old.z), sigm(v1[1]) * bf_hi(old.z));
                    w.w = cvt_pk_bf16(sigm(v1[2]) * bf_lo(old.w), sigm(v1[3]) * bf_hi(old.w));
                    *(u32x4*)(rowp + bj * HALF) = w;
                }
            }
    }
};
struct EpiFF1 {
    static constexpr bool PERM = true, AFTER_DRAIN = false;
    bf16_t* O; int ldc; const float* ss; float eps;
    __device__ __forceinline__ void operator()(const f32x4 (&acc)[2][2][4][2], const Unit& u, int wr, int wc, int fr, int fq) const {
        const int row0 = u.pm * BM + wr * 64 + fr, col0 = u.pn * BM + wc * 32 + 8 * fq;
#pragma unroll
        for (int ai = 0; ai < 2; ++ai)
#pragma unroll
            for (int m = 0; m < 4; ++m) {
                const int row = row0 + ai * HALF + m * 16; bf16_t* rowp = O + (size_t)row * ldc + col0;
                const f32x4 q = *(const f32x4*)(ss + (size_t)row * 4);
                const float rstd = __builtin_amdgcn_rsqf(((q[0] + q[1]) + (q[2] + q[3])) * (1.0f / 1024.0f) + eps);
#pragma unroll
                for (int bj = 0; bj < 2; ++bj) {
                    f32x4 v0 = acc[ai][bj][m][0] * rstd, v1 = acc[ai][bj][m][1] * rstd;
#pragma unroll
                    for (int e = 0; e < 4; ++e) { const float a = fmaxf(v0[e], 0.f), b = fmaxf(v1[e], 0.f); v0[e] = a * a; v1[e] = b * b; }
                    u32x4 w; w.x = cvt_pk_bf16(v0[0], v0[1]); w.y = cvt_pk_bf16(v0[2], v0[3]); w.z = cvt_pk_bf16(v1[0], v1[1]); w.w = cvt_pk_bf16(v1[2], v1[3]);
                    *(u32x4*)(rowp + bj * HALF) = w;
                }
            }
    }
};
struct EpiRes {
    static constexpr bool PERM = false, AFTER_DRAIN = true;
    const float* base; float* out; bf16_t* outb; float* ss;
    __device__ __forceinline__ void fused(f32x4 (&acc)[2][2][4][2], const Unit& u, int wr, int wc, int fr, int fq, PG8_LAS unsigned char* lds, int wid, int lane) const {
        typedef unsigned u32x2v __attribute__((ext_vector_type(2)));
        PG8_LAS float* P = (PG8_LAS float*)lds;
        const int col0 = u.pn * BM + wc * 32 + 4 * fq;
#pragma unroll
        for (int ai = 0; ai < 2; ++ai)
#pragma unroll
            for (int m = 0; m < 4; ++m) {
                const int r = ai * HALF + wr * 64 + m * 16 + fr; const size_t off = (size_t)(u.pm * BM + r) * 1024 + col0; float s = 0.f;
#pragma unroll
                for (int bj = 0; bj < 2; ++bj)
#pragma unroll
                    for (int n = 0; n < 2; ++n) {
                        const f32x4 bs = *(const f32x4*)(base + off + bj * HALF + n * 16); const f32x4 o = bs + acc[ai][bj][m][n];
                        *(f32x4*)(out + off + bj * HALF + n * 16) = o; s += (o[0] * o[0] + o[1] * o[1]) + (o[2] * o[2] + o[3] * o[3]);
                        if (outb) { u32x2v w; w.x = cvt_pk_bf16(o[0], o[1]); w.y = cvt_pk_bf16(o[2], o[3]); *(u32x2v*)(outb + off + bj * HALF + n * 16) = w; }
                    }
                s += __shfl_xor(s, 16); s += __shfl_xor(s, 32);
                if (fq == 0) P[r * 4 + wc] = s;
                if (m & 1) asm volatile("" ::: "memory");
            }
        asm volatile("s_waitcnt lgkmcnt(0)" ::: "memory"); __builtin_amdgcn_s_barrier(); asm volatile("" ::: "memory");
        const int tid = wid * 64 + lane;
        if (tid < 256) { const float t = (P[tid * 4 + 0] + P[tid * 4 + 1]) + (P[tid * 4 + 2] + P[tid * 4 + 3]); ss[(size_t)(u.pm * BM + tid) * 4 + u.pn] = t; }
        asm volatile("s_waitcnt lgkmcnt(0)" ::: "memory"); __builtin_amdgcn_s_barrier(); asm volatile("" ::: "memory");
    }
};
template <class Epi, class Sched, bool ALIGN_EPI = false, bool SP2 = false>
__device__ __forceinline__ void gemm_phase(PG8_LAS unsigned char* lds, const Gemm g, const Sched& S, const Epi& E) {
    const int tid = threadIdx.x, wid = __builtin_amdgcn_readfirstlane(tid >> 6), lane = tid & 63, wr = wid >> 2, wc = wid & 3, fr = lane & 15, fq = lane >> 4;
    const int K = g.K, nt = K / BK;
    unsigned voffA[2], voffB[2];
#pragma unroll
    for (int i = 0; i < 2; ++i) { int R, C; stage_rc(tid * 16 + i * 8192, R, C); const int Rb = Epi::PERM ? ((R & ~31) + perm32(R & 31)) : R;
        voffA[i] = (unsigned)(R * K + C) * 2u; voffB[i] = (unsigned)(Rb * K + C) * 2u; }
    const size_t kstep = (size_t)(BK * 2);
    const size_t hstep = (size_t)HALF * K * 2;
    const size_t tstep = 2 * hstep;
    const unsigned ldsw = (unsigned)wid * 1024u;
    const int aoff = lds_byte(wr * 64 + fr, fq * 8), boff = lds_byte(wc * 32 + fr, fq * 8);
#define PG8_SA(b, h) (((b) * 2 + (h)) * HTB)
#define PG8_SB(b, h) ((4 + (b) * 2 + (h)) * HTB)
#define PG8_STAGE(bufoff, gbase, voff) do { _Pragma("unroll") for (int _i = 0; _i < 2; ++_i) \
        __builtin_amdgcn_global_load_lds((const unsigned*)((const char*)(gbase) + (voff)[_i]), (PG8_LAS unsigned*)(lds + (bufoff) + ldsw + _i * 8192), 16, 0, 0); } while (0)
#define PG8_LDA(dst, b, h) do { _Pragma("unroll") for (int m = 0; m < 4; ++m) _Pragma("unroll") for (int k = 0; k < 2; ++k) dst[m][k] = *(const PG8_LAS bf16x8*)(lds + PG8_SA(b, h) + aoff + m * 2048 + k * 1024); } while (0)
#define PG8_LDB(dst, b, h) do { _Pragma("unroll") for (int n = 0; n < 2; ++n) _Pragma("unroll") for (int k = 0; k < 2; ++k) dst[n][k] = *(const PG8_LAS bf16x8*)(lds + PG8_SB(b, h) + boff + n * 2048 + k * 1024); } while (0)
#define PG8_MMA(ai, bj, At, Bt) do { __builtin_amdgcn_s_setprio(1); _Pragma("unroll") for (int m = 0; m < 4; ++m) _Pragma("unroll") for (int n = 0; n < 2; ++n) _Pragma("unroll") for (int k = 0; k < 2; ++k) \
        acc[ai][bj][m][n] = __builtin_amdgcn_mfma_f32_16x16x32_bf16(Bt[n][k], At[m][k], acc[ai][bj][m][n], 0, 0, 0); __builtin_amdgcn_s_setprio(0); } while (0)
#define PG8_WAIT_V(n) asm volatile("s_waitcnt vmcnt(" #n ")" ::: "memory")
#define PG8_WAIT_L(n) asm volatile("s_waitcnt lgkmcnt(" #n ")" ::: "memory")
#define PG8_BAR __builtin_amdgcn_s_barrier()
#define PG8_SCHED __builtin_amdgcn_sched_barrier(0)
    Unit cur, nxt; int ui = 0;
    if (!S.next(0, cur)) return;
    f32x4 acc[2][2][4][2];
#pragma unroll
    for (int a = 0; a < 2; ++a)
#pragma unroll
        for (int b = 0; b < 2; ++b)
#pragma unroll
            for (int m = 0; m < 4; ++m)
#pragma unroll
                for (int n = 0; n < 2; ++n) acc[a][b][m][n] = (f32x4){0.f, 0.f, 0.f, 0.f};
    bf16x8 At[4][2], B0[2][2], B1[2][2];
    const char* cA = (const char*)(cur.pn >= g.pn_split ? g.A2 : g.A) + (size_t)cur.pm * tstep; const char* cB = (const char*)g.Bt + (size_t)cur.pn * tstep;
    S.a_ready(cur);
    if constexpr (SP2) {
        PG8_STAGE(PG8_SB(0, 0), cB, voffB); PG8_STAGE(PG8_SB(0, 1), cB + hstep, voffB); PG8_STAGE(PG8_SA(0, 0), cA, voffA); PG8_STAGE(PG8_SA(0, 1), cA + hstep, voffA);
        if (wr == 1) PG8_BAR;
        PG8_WAIT_V(2); PG8_BAR;
        PG8_STAGE(PG8_SB(1, 0), cB + kstep, voffB); PG8_STAGE(PG8_SA(1, 0), cA + kstep, voffA); PG8_STAGE(PG8_SB(1, 1), cB + hstep + kstep, voffB);
        PG8_WAIT_V(6); PG8_BAR;
    } else {
        PG8_STAGE(PG8_SB(0, 0), cB, voffB); PG8_STAGE(PG8_SA(0, 0), cA, voffA); PG8_STAGE(PG8_SB(0, 1), cB + hstep, voffB); PG8_STAGE(PG8_SA(0, 1), cA + hstep, voffA);
        if (wr == 1) PG8_BAR;
        PG8_WAIT_V(4); PG8_BAR;
        PG8_STAGE(PG8_SB(1, 0), cB + kstep, voffB); PG8_STAGE(PG8_SA(1, 0), cA + kstep, voffA); PG8_STAGE(PG8_SB(1, 1), cB + hstep + kstep, voffB);
        PG8_WAIT_V(6); PG8_BAR;
    }
    for (;;) {
        const bool has_next = S.next(ui + 1, nxt);
        const char* nA = has_next ? (const char*)(nxt.pn >= g.pn_split ? g.A2 : g.A) + (size_t)nxt.pm * tstep : cA; const char* nB = has_next ? (const char*)g.Bt + (size_t)nxt.pn * tstep : cB;
        for (int t = 0; t < nt; t += 2) {
            const bool last = (t == nt - 2);
            const char* a1 = cA + (size_t)(t + 1) * kstep;
            const char* a2 = last ? nA : cA + (size_t)(t + 2) * kstep; const char* b2 = last ? nB : cB + (size_t)(t + 2) * kstep;
            const char* a3 = a2 + kstep; const char* b3 = b2 + kstep;
            if (last && has_next) S.a_ready(nxt);
            if constexpr (SP2) {
            PG8_LDB(B0, 0, 0); PG8_LDB(B1, 0, 1); PG8_SCHED; PG8_LDA(At, 0, 0); PG8_STAGE(PG8_SA(1, 1), a1 + hstep, voffA);
            PG8_WAIT_V(8); PG8_WAIT_L(0); PG8_BAR; PG8_MMA(0, 0, At, B0); PG8_MMA(0, 1, At, B1); PG8_BAR; PG8_SCHED;
            PG8_LDA(At, 0, 1); PG8_STAGE(PG8_SB(0, 0), b2, voffB); PG8_STAGE(PG8_SB(0, 1), b2 + hstep, voffB); PG8_STAGE(PG8_SA(0, 0), a2, voffA);
            PG8_WAIT_V(8); PG8_WAIT_L(0); PG8_BAR; PG8_MMA(1, 0, At, B0); PG8_MMA(1, 1, At, B1); PG8_BAR; PG8_SCHED;
            PG8_LDB(B0, 1, 0); PG8_LDB(B1, 1, 1); PG8_SCHED; PG8_LDA(At, 1, 0); PG8_STAGE(PG8_SA(0, 1), a2 + hstep, voffA);
            PG8_WAIT_V(8); PG8_WAIT_L(0); PG8_BAR; PG8_MMA(0, 0, At, B0); PG8_MMA(0, 1, At, B1); PG8_BAR; PG8_SCHED;
            PG8_LDA(At, 1, 1); PG8_STAGE(PG8_SB(1, 0), b3, voffB); PG8_STAGE(PG8_SB(1, 1), b3 + hstep, voffB); PG8_STAGE(PG8_SA(1, 0), a3, voffA);
            PG8_WAIT_V(8); PG8_WAIT_L(0); PG8_BAR; PG8_MMA(1, 0, At, B0); PG8_MMA(1, 1, At, B1); PG8_BAR; PG8_SCHED;
            } else {
            PG8_LDB(B0, 0, 0); PG8_SCHED; PG8_LDA(At, 0, 0); PG8_STAGE(PG8_SA(1, 1), a1 + hstep, voffA);
            PG8_WAIT_L(8); PG8_BAR; PG8_WAIT_L(0); PG8_MMA(0, 0, At, B0); PG8_BAR; PG8_SCHED;
            PG8_LDB(B1, 0, 1); PG8_STAGE(PG8_SB(0, 0), b2, voffB);
            PG8_BAR; PG8_WAIT_L(0); PG8_MMA(0, 1, At, B1); PG8_BAR;
            PG8_LDA(At, 0, 1); PG8_STAGE(PG8_SA(0, 0), a2, voffA);
            PG8_BAR; PG8_WAIT_L(0); PG8_MMA(1, 0, At, B0); PG8_BAR; PG8_SCHED;
            PG8_STAGE(PG8_SB(0, 1), b2 + hstep, voffB);
            PG8_WAIT_V(6); PG8_BAR; PG8_MMA(1, 1, At, B1); PG8_BAR;
            PG8_LDB(B0, 1, 0); PG8_SCHED; PG8_LDA(At, 1, 0); PG8_STAGE(PG8_SA(0, 1), a2 + hstep, voffA);
            PG8_WAIT_L(8); PG8_BAR; PG8_WAIT_L(0); PG8_MMA(0, 0, At, B0); PG8_BAR; PG8_SCHED;
            PG8_LDB(B1, 1, 1); PG8_STAGE(PG8_SB(1, 0), b3, voffB);
            PG8_BAR; PG8_WAIT_L(0); PG8_MMA(0, 1, At, B1); PG8_BAR;
            PG8_LDA(At, 1, 1); PG8_STAGE(PG8_SA(1, 0), a3, voffA);
            PG8_BAR; PG8_WAIT_L(0); PG8_MMA(1, 0, At, B0); PG8_BAR; PG8_SCHED;
            PG8_STAGE(PG8_SB(1, 1), b3 + hstep, voffB);
            PG8_WAIT_V(6); PG8_BAR; PG8_MMA(1, 1, At, B1); PG8_BAR;
            }
        }
        if constexpr (ALIGN_EPI) { if (wr == 0) PG8_BAR; }
        if constexpr (!Epi::AFTER_DRAIN) { E(acc, cur, wr, wc, fr, fq); S.done(cur); }
        if (!has_next) break;
#pragma unroll
        for (int a = 0; a < 2; ++a)
#pragma unroll
            for (int b = 0; b < 2; ++b)
#pragma unroll
                for (int m = 0; m < 4; ++m)
#pragma unroll
                    for (int n = 0; n < 2; ++n) acc[a][b][m][n] = (f32x4){0.f, 0.f, 0.f, 0.f};
        cur = nxt; cA = nA; cB = nB; ++ui;
        if constexpr (ALIGN_EPI) { if (wr == 1) PG8_BAR; }
    }
    PG8_WAIT_V(0);
    if constexpr (!ALIGN_EPI) { if (wr == 0) PG8_BAR; }
    PG8_BAR;
    if constexpr (Epi::AFTER_DRAIN) { E.fused(acc, cur, wr, wc, fr, fq, lds, wid, lane); S.done(cur); }
#undef PG8_SA
#undef PG8_SB
#undef PG8_STAGE
#undef PG8_LDA
#undef PG8_LDB
#undef PG8_MMA
#undef PG8_WAIT_V
#undef PG8_WAIT_L
#undef PG8_BAR
#undef PG8_SCHED
}
}
#include <hip/hip_bf16.h>
#include <cmath>
namespace attn_body {
using bf16=__hip_bfloat16;
using bf16x8=__attribute__((ext_vector_type(8)))short;
using s16x4=__attribute__((ext_vector_type(4)))short;
using f32x16=__attribute__((ext_vector_type(16)))float;
using u32x4=__attribute__((ext_vector_type(4)))unsigned;
constexpr int BATCH=4,SEQ=4096,D=64,DM=1024,OPITCH=2048;
constexpr int NW=8,QBLK=32,QB=QBLK*NW,KVBLK=64,NQB=SEQ/QB;
constexpr int ATTN_PITCH=DM, ATTN_UNIT_ROWS=QB;
__device__ __forceinline__ int crow(int r,int hi){return (r&3)+8*(r>>2)+4*hi;}
#define SBAR() __builtin_amdgcn_sched_barrier(0)
__device__ __forceinline__ void cmask(f32x16&p0,f32x16&p1,int jb,int qrel,int hi){
  const float NEG=-INFINITY; int kb=64*jb+4*hi;
  #pragma unroll
  for(int r=0;r<16;++r){int kv=kb+(r&3)+8*(r>>2); if(kv>qrel)p0[r]=NEG; if(kv+32>qrel)p1[r]=NEG;}
}

constexpr int NSLOT=3, SLOTB=8192;
constexpr int LDS_K=0, LDS_V=NSLOT*SLOTB, LDS_WS=2*NSLOT*SLOTB, LDS_OST=LDS_WS+NW*64*4, LDS_BYTES=LDS_OST+NW*4096;
constexpr float C2=0.125f*1.4426950408889634f;
__device__ __forceinline__ void glds16(const void*gsrc,unsigned lds_dst){unsigned keep;
  asm volatile("s_mov_b32 %0, m0\n\ts_mov_b32 m0, %2\n\ts_nop 0\n\tglobal_load_lds_dwordx4 %1, off\n\ts_mov_b32 m0, %0":"=&s"(keep):"v"(gsrc),"s"(lds_dst):"memory");}
__device__ __forceinline__ float max3f(float a,float b,float c){float r;asm("v_max3_f32 %0, %1, %2, %3":"=v"(r):"v"(a),"v"(b),"v"(c));return r;}
__device__ __forceinline__ float max2f(float a,float b){float r;asm("v_max_f32_e32 %0, %1, %2":"=v"(r):"v"(a),"v"(b));return r;}
__device__ __forceinline__ float fadd_s(float a,float b){float r;asm("v_add_f32_e32 %0, %1, %2":"=v"(r):"v"(a),"v"(b));return r;}
__device__ __forceinline__ float fsub_s(float a,float b){float r;asm("v_sub_f32_e32 %0, %1, %2":"=v"(r):"v"(a),"v"(b));return r;}
typedef float f32x2_t __attribute__((ext_vector_type(2))); typedef __bf16 bf16x2_t __attribute__((ext_vector_type(2)));
__device__ __forceinline__ unsigned cvtpk_s(float lo,float hi){f32x2_t v={lo,hi};bf16x2_t b=__builtin_convertvector(v,bf16x2_t);return __builtin_bit_cast(unsigned,b);}
#define WAIT_BAR(N) asm volatile("s_waitcnt vmcnt(" #N ") lgkmcnt(0)\n\ts_barrier":::"memory")

__device__ __forceinline__ void qkt(f32x16&p0,f32x16&p1,const char*Kslot,const bf16x8*qr,const f32x16&negm,int r32,int hi){
  const char*kb=Kslot+hi*1024+r32*16;
  #pragma unroll
  for(int d0=0;d0<4;++d0){
    const bf16x8 b0=*reinterpret_cast<const bf16x8*>(kb+d0*2048);
    const bf16x8 b1=*reinterpret_cast<const bf16x8*>(kb+d0*2048+512);
    if(d0==0){p0=__builtin_amdgcn_mfma_f32_32x32x16_bf16(b0,qr[0],negm,0,0,0);p1=__builtin_amdgcn_mfma_f32_32x32x16_bf16(b1,qr[0],negm,0,0,0);}
    else{p0=__builtin_amdgcn_mfma_f32_32x32x16_bf16(b0,qr[d0],p0,0,0,0);p1=__builtin_amdgcn_mfma_f32_32x32x16_bf16(b1,qr[d0],p1,0,0,0);}}
}
typedef __attribute__((address_space(3))) const char* lds_cptr;
typedef short v4i16_t __attribute__((ext_vector_type(4)));
__device__ __forceinline__ void kload8(bf16x8*kf,lds_cptr kp){
  kf[0]=*(const __attribute__((address_space(3))) bf16x8*)(kp);      kf[1]=*(const __attribute__((address_space(3))) bf16x8*)(kp+512);
  kf[2]=*(const __attribute__((address_space(3))) bf16x8*)(kp+2048); kf[3]=*(const __attribute__((address_space(3))) bf16x8*)(kp+2560);
  kf[4]=*(const __attribute__((address_space(3))) bf16x8*)(kp+4096); kf[5]=*(const __attribute__((address_space(3))) bf16x8*)(kp+4608);
  kf[6]=*(const __attribute__((address_space(3))) bf16x8*)(kp+6144); kf[7]=*(const __attribute__((address_space(3))) bf16x8*)(kp+6656);
}
__device__ __forceinline__ void kload2(bf16x8*kf,lds_cptr kp,int j){ kf[2*j]=*(const __attribute__((address_space(3))) bf16x8*)(kp+j*2048); kf[2*j+1]=*(const __attribute__((address_space(3))) bf16x8*)(kp+j*2048+512); }
__device__ __forceinline__ s16x4 vtr(lds_cptr p){ return __builtin_bit_cast(s16x4,__builtin_amdgcn_ds_read_tr16_b64_v4i16((__attribute__((address_space(3))) v4i16_t*)p)); }
__device__ __forceinline__ float rowmax(const f32x16&p0,const f32x16&p1){
  float a=max3f(p0[0],p0[1],p1[0]),b=max3f(p0[2],p0[3],p1[1]);a=max3f(a,p1[2],p1[3]);
  #pragma unroll
  for(int r=4;r<16;r+=4){a=max3f(a,p0[r],p0[r+1]);b=max3f(b,p0[r+2],p0[r+3]);a=max3f(a,p1[r],p1[r+1]);b=max3f(b,p1[r+2],p1[r+3]);}
  const float m=max2f(a,b);
  auto rr=__builtin_amdgcn_permlane32_swap(__float_as_uint(m),__float_as_uint(m),false,false);
  return max2f(__uint_as_float(rr[0]),__uint_as_float(rr[1]));
}
__device__ __forceinline__ void pv(f32x16*o,int vb,bf16x8 pa0,bf16x8 pa1,bf16x8 pa2,bf16x8 pa3){
  #pragma unroll
  for(int d0=0;d0<2;++d0){s16x4 lo[4],hi[4];
    #pragma unroll
    for(int ks=0;ks<4;++ks){
      asm volatile("ds_read_b64_tr_b16 %0,%1 offset:%c2":"=&v"(lo[ks]):"v"(vb),"i"(d0*4096+ks*1024):"memory");
      asm volatile("ds_read_b64_tr_b16 %0,%1 offset:%c2":"=&v"(hi[ks]):"v"(vb),"i"(d0*4096+ks*1024+512):"memory");}
    asm volatile("s_waitcnt lgkmcnt(0)":::"memory");SBAR();
    #define PK(k) (bf16x8){lo[k][0],lo[k][1],lo[k][2],lo[k][3],hi[k][0],hi[k][1],hi[k][2],hi[k][3]}
    o[d0]=__builtin_amdgcn_mfma_f32_32x32x16_bf16(pa0,PK(0),o[d0],0,0,0);
    o[d0]=__builtin_amdgcn_mfma_f32_32x32x16_bf16(pa1,PK(1),o[d0],0,0,0);
    o[d0]=__builtin_amdgcn_mfma_f32_32x32x16_bf16(pa2,PK(2),o[d0],0,0,0);
    o[d0]=__builtin_amdgcn_mfma_f32_32x32x16_bf16(pa3,PK(3),o[d0],0,0,0);
    #undef PK
  }
}

#ifndef ATTN_STORE16
#define ATTN_STORE16(p,v) (*(u32x4*)(p)=(v))
#endif
template<int THRL> __device__ __forceinline__ void attn_unit(int b,int qcol,int vcol,int ocol,int qb,const bf16*Q,const bf16*__restrict__ K,const bf16*__restrict__ V,bf16*O,char*shm){
  int tid=threadIdx.x; asm volatile("":"+v"(tid));
  const int lane=tid&63,r32=lane&31,hi=lane>>5; const int wid=__builtin_amdgcn_readfirstlane(tid>>6);
  const long rowbase=(long)b*SEQ; const int q0=qb*QB;
  const bf16*Qw=Q+(rowbase+q0+wid*QBLK)*DM+qcol;
  const bf16*Kh=K+rowbase*DM+qcol,*Vh=V+rowbase*DM+vcol;
  const unsigned lds0=(unsigned)(uintptr_t)shm;
  float*wsf=(float*)(shm+LDS_WS)+wid*64;
  const bf16*ksrc=Kh+(long)lane*DM+wid*8;
  const bf16*vsrc=Vh+(long)(16*(wid&3)+(lane>>2))*DM+(wid>>2)*32+(lane&3)*8;
  const unsigned kdst=lds0+LDS_K+wid*1024, vdst=lds0+LDS_V+wid*1024;
  #define DMA_K(t,slot) glds16(ksrc+(long)(t)*KVBLK*DM,(unsigned)__builtin_amdgcn_readfirstlane(kdst+(slot)))
  #define DMA_V(t,slot) glds16(vsrc+(long)(t)*KVBLK*DM,(unsigned)__builtin_amdgcn_readfirstlane(vdst+(slot)))
  const int vb0=(int)(lds0+LDS_V)+((lane>>4)&1)*32+(lane&3)*8+(4*hi+((lane&15)>>2))*64;
  const char*Kbase=shm+LDS_K; bf16x8 kf[8];
  const lds_cptr shm3=(lds_cptr)shm; const lds_cptr kp0=shm3+LDS_K+hi*1024+r32*16; const lds_cptr vp0=shm3+LDS_V+((lane>>4)&1)*32+(lane&3)*8+(4*hi+((lane&15)>>2))*64;
  const int NT=(q0+QB)/KVBLK;
  DMA_K(0,0);DMA_V(0,0);DMA_K(1,SLOTB);
  bf16x8 qr[4];
  #pragma unroll
  for(int d0=0;d0<4;++d0)qr[d0]=*reinterpret_cast<const bf16x8*>(&Qw[(long)r32*DM+d0*16+hi*8]);
  float mhat=0.f,l_reg=0.f;f32x16 o[2];o[0]=f32x16{};o[1]=f32x16{};asm volatile("":"+v"(o[0]),"+v"(o[1]));f32x16 negm=f32x16{};asm volatile("":"+v"(negm));
  const int qrel=wid*QBLK+r32;
  #define CMASK(P0,P1,t) do{int jb_=(t)-(NT-4); if(jb_>=0)cmask(P0,P1,jb_,qrel,hi);}while(0)
  bool resc=false;
  #define START(P0,P1) do{ const float rm=rowmax(P0,P1); resc=false; \
    { const float dl=rm; mhat=fadd_s(mhat,dl); \
      _Pragma("unroll") for(int r=0;r<16;++r){P0[r]=fsub_s(P0[r],dl);P1[r]=fsub_s(P1[r],dl);} \
      _Pragma("unroll") for(int r=0;r<16;++r)negm[r]=-mhat; asm volatile("":"+v"(negm)); } \
    _Pragma("unroll") for(int r=0;r<16;++r)P0[r]=__builtin_amdgcn_exp2f(P0[r]); }while(0)
  #define RESC() do{ if(resc){ asm volatile("s_waitcnt lgkmcnt(0)":::"memory"); \
      _Pragma("unroll") for(int d_=0;d_<2;++d_) _Pragma("unroll") for(int r=0;r<16;++r)o[d_][r]*=wsf[crow(r,hi)]; } }while(0)
  f32x16 pA0,pA1,pB0,pB1;
  int sl_prev=0,sl_cur=0,sl_next=SLOTB;
  #define ROT() do{sl_prev=sl_cur;sl_cur=sl_next;sl_next=(sl_next==(NSLOT-1)*SLOTB)?0:sl_next+SLOTB;}while(0)
  DMA_K(2,2*SLOTB);
  WAIT_BAR(3);
  qkt(pA0,pA1,Kbase,qr,negm,r32,hi);asm volatile("s_nop 15\n\ts_nop 7":"+v"(pA0),"+v"(pA1));CMASK(pA0,pA1,0);
  START(pA0,pA1);
  _Pragma("unroll") for(int r=0;r<16;++r)pA1[r]=__builtin_amdgcn_exp2f(pA1[r]);
  WAIT_BAR(0);
  DMA_K(3,0);DMA_V(1,SLOTB);
  ROT();
  kload8(kf,kp0+sl_cur);
  WAIT_BAR(2);
  s16x4 vlo[8],vhi[8]; u32x4 pw0,pw1,pw2,pw3;
  #define PKW(P,B) cvtpk_s(P[B],P[B+1])
  #define PAF(k) __builtin_bit_cast(bf16x8,pw##k)
  #define VFR(i) (bf16x8){vlo[i][0],vlo[i][1],vlo[i][2],vlo[i][3],vhi[i][0],vhi[i][1],vhi[i][2],vhi[i][3]}
  #define PIN(x) asm volatile("":"+v"(x))
  #define MX3(a,b,c) __builtin_fmaxf(__builtin_fmaxf((a),(b)),(c))
  #define GAPA(MF,A0,A1,A2,A3,W0,W1,PW) do{ MF; sacc+=A0; sacc+=A1; sacc+=A2; sacc+=A3; PIN(sacc); W0; W1; PIN(PW); SBAR(); }while(0)
  #define EX(v) __builtin_amdgcn_exp2f(v)
  #define GAPB(MF,X,B) do{ MF; X[B]=EX(X[B]); X[B+1]=EX(X[B+1]); X[B+2]=EX(X[B+2]); X[B+3]=EX(X[B+3]); PIN(X); SBAR(); }while(0)
  #define VRD(i) do{ vlo[i]=vtr(vp_+(((i)>>2)*4096+((i)&3)*1024)); vhi[i]=vtr(vp_+(((i)>>2)*4096+((i)&3)*1024+512)); }while(0)
  #define KRD(G,j) do{ if(G){ kload2(kf,kp0+sl_next,j); SBAR(); } }while(0)
  #define STEP(C0,C1,P0,P1,t,GK,GV,GL) do{ SBAR(); \
    const lds_cptr vp_=vp0+sl_prev; \
    VRD(0); SBAR(); float sacc=(P0[0]+P0[1]); \
    GAPA(C0=__builtin_amdgcn_mfma_f32_32x32x16_bf16(kf[0],qr[0],negm,0,0,0), P0[2],P0[3],P0[4],P0[5],     pw0[0]=PKW(P0,0), pw0[1]=PKW(P0,2), pw0); \
    VRD(4); SBAR(); GAPA(C1=__builtin_amdgcn_mfma_f32_32x32x16_bf16(kf[1],qr[0],negm,0,0,0), P0[6],P0[7],P0[8],P0[9],     pw0[2]=PKW(P0,4), pw0[3]=PKW(P0,6), pw0); \
    VRD(1); SBAR(); GAPA(C0=__builtin_amdgcn_mfma_f32_32x32x16_bf16(kf[2],qr[1],C0,0,0,0),   P0[10],P0[11],P0[12],P0[13], pw1[0]=PKW(P0,8), pw1[1]=PKW(P0,10), pw1); \
    VRD(5); SBAR(); GAPA(C1=__builtin_amdgcn_mfma_f32_32x32x16_bf16(kf[3],qr[1],C1,0,0,0),   P0[14],P0[15],P1[0],P1[1],   pw1[2]=PKW(P0,12),pw1[3]=PKW(P0,14), pw1); \
    VRD(2); SBAR(); GAPA(C0=__builtin_amdgcn_mfma_f32_32x32x16_bf16(kf[4],qr[2],C0,0,0,0),   P1[2],P1[3],P1[4],P1[5],     pw2[0]=PKW(P1,0), pw2[1]=PKW(P1,2), pw2); \
    VRD(6); SBAR(); GAPA(C1=__builtin_amdgcn_mfma_f32_32x32x16_bf16(kf[5],qr[2],C1,0,0,0),   P1[6],P1[7],P1[8],P1[9],     pw2[2]=PKW(P1,4), pw2[3]=PKW(P1,6), pw2); \
    VRD(3); SBAR(); GAPA(C0=__builtin_amdgcn_mfma_f32_32x32x16_bf16(kf[6],qr[3],C0,0,0,0),   P1[10],P1[11],P1[12],P1[13], pw3[0]=PKW(P1,8), pw3[1]=PKW(P1,10), pw3); \
    VRD(7); SBAR(); GAPA(C1=__builtin_amdgcn_mfma_f32_32x32x16_bf16(kf[7],qr[3],C1,0,0,0),   P1[14],P1[15],0.f,0.f,       pw3[2]=PKW(P1,12),pw3[3]=PKW(P1,14), pw3); \
    l_reg+=sacc; \
    if(GK){DMA_K((t)+3,sl_cur);} if(GV){DMA_V((t)+1,sl_next);} \
    CMASK(C0,C1,t); \
    { float a=MX3(C0[0],C0[1],C1[0]),b=MX3(C0[2],C0[3],C1[1]); a=MX3(a,C1[2],C1[3]); \
      _Pragma("unroll") for(int r=4;r<16;r+=4){a=MX3(a,C0[r],C0[r+1]);b=MX3(b,C0[r+2],C0[r+3]);a=MX3(a,C1[r],C1[r+1]);b=MX3(b,C1[r+2],C1[r+3]);} \
      float rm=__builtin_fmaxf(a,b); { auto rr=__builtin_amdgcn_permlane32_swap(__float_as_uint(rm),__float_as_uint(rm),false,false); rm=__builtin_fmaxf(__uint_as_float(rr[0]),__uint_as_float(rr[1])); } \
      resc=false; \
      if(__builtin_expect(__any(rm>(float)THRL),0)){ const float dl=__builtin_fmaxf(rm,0.f); mhat+=dl; \
        _Pragma("unroll") for(int r=0;r<16;++r){C0[r]-=dl;C1[r]-=dl;} \
        _Pragma("unroll") for(int r=0;r<16;++r)negm[r]=-mhat; asm volatile("":"+v"(negm)); \
        const float f=__builtin_amdgcn_exp2f(-dl); l_reg*=f; if(hi==0)wsf[r32]=f; resc=true; } } \
    SBAR(); \
    GAPB(o[0]=__builtin_amdgcn_mfma_f32_32x32x16_bf16(PAF(0),VFR(0),o[0],0,0,0), C0,0); \
    GAPB(o[1]=__builtin_amdgcn_mfma_f32_32x32x16_bf16(PAF(0),VFR(4),o[1],0,0,0), C0,4); \
    KRD(GL,0); GAPB(o[0]=__builtin_amdgcn_mfma_f32_32x32x16_bf16(PAF(1),VFR(1),o[0],0,0,0), C0,8); \
    KRD(GL,1); GAPB(o[1]=__builtin_amdgcn_mfma_f32_32x32x16_bf16(PAF(1),VFR(5),o[1],0,0,0), C0,12); \
    KRD(GL,2); GAPB(o[0]=__builtin_amdgcn_mfma_f32_32x32x16_bf16(PAF(2),VFR(2),o[0],0,0,0), C1,0); \
    KRD(GL,3); GAPB(o[1]=__builtin_amdgcn_mfma_f32_32x32x16_bf16(PAF(2),VFR(6),o[1],0,0,0), C1,4); \
    GAPB(o[0]=__builtin_amdgcn_mfma_f32_32x32x16_bf16(PAF(3),VFR(3),o[0],0,0,0), C1,8); \
    GAPB(o[1]=__builtin_amdgcn_mfma_f32_32x32x16_bf16(PAF(3),VFR(7),o[1],0,0,0), C1,12); \
    }while(0)
  int t=1;
  #undef CMASK
  #define CMASK(P0,P1,t) do{}while(0)
  for(;t+5<NT;t+=2){
    STEP(pB0,pB1,pA0,pA1,t,true,true,true);     WAIT_BAR(2); RESC(); ROT();
    STEP(pA0,pA1,pB0,pB1,t+1,true,true,true);   WAIT_BAR(2); RESC(); ROT();
  }
  #undef CMASK
  #define CMASK(P0,P1,t) do{int jb_=(t)-(NT-4); if(jb_>=0)cmask(P0,P1,jb_,qrel,hi);}while(0)
  #define ENDW(tt) do{ if((tt)+3<NT){WAIT_BAR(2);} else if((tt)+2<NT){WAIT_BAR(1);} else {WAIT_BAR(0);} }while(0)
  for(;t+1<NT;t+=2){
    STEP(pB0,pB1,pA0,pA1,t,(t+3<NT),(t+1<NT),(t+1<NT));       ENDW(t);   RESC(); ROT();
    STEP(pA0,pA1,pB0,pB1,t+1,(t+4<NT),(t+2<NT),(t+2<NT));     ENDW(t+1); RESC(); ROT();
  }
  STEP(pB0,pB1,pA0,pA1,NT-1,false,false,false); RESC();
  { float sacc=pB0[0]+pB0[1]; _Pragma("unroll") for(int r=2;r<16;++r)sacc+=pB0[r]; _Pragma("unroll") for(int r=0;r<16;++r)sacc+=pB1[r]; l_reg+=sacc;
    pw0=(u32x4){PKW(pB0,0),PKW(pB0,2),PKW(pB0,4),PKW(pB0,6)};pw1=(u32x4){PKW(pB0,8),PKW(pB0,10),PKW(pB0,12),PKW(pB0,14)};pw2=(u32x4){PKW(pB1,0),PKW(pB1,2),PKW(pB1,4),PKW(pB1,6)};pw3=(u32x4){PKW(pB1,8),PKW(pB1,10),PKW(pB1,12),PKW(pB1,14)};
    SBAR(); pv(o,vb0+sl_cur,PAF(0),PAF(1),PAF(2),PAF(3)); }
  #undef PKW
  #undef PAF
  #undef VFR
  #undef PIN
  #undef MX3
  #undef GAPA
  #undef GAPB
  #undef EX
  #undef VRD
  #undef KRD
  #undef STEP
  #undef ENDW
  {auto rr=__builtin_amdgcn_permlane32_swap(__float_as_uint(l_reg),__float_as_uint(l_reg),false,false);l_reg=__uint_as_float(rr[0])+__uint_as_float(rr[1]);}
  if(hi==0)wsf[32+r32]=l_reg;asm volatile("s_waitcnt lgkmcnt(0)":::"memory");
  float rli[16];
  #pragma unroll
  for(int r=0;r<16;++r)rli[r]=__builtin_amdgcn_rcpf(wsf[32+crow(r,hi)]);
  bf16*Ow=O+(rowbase+q0+wid*QBLK)*OPITCH+ocol;
  { bf16*stg=(bf16*)(shm+LDS_OST)+wid*2048;
    #pragma unroll
    for(int r=0;r<16;++r){const int orow=crow(r,hi);
      #pragma unroll
      for(int d0=0;d0<2;++d0)stg[orow*64+d0*32+r32]=__float2bfloat16(o[d0][r]*rli[r]);}
    asm volatile("s_waitcnt lgkmcnt(0)":::"memory");
    int lane2=lane; asm volatile("":"+v"(lane2));
    #pragma unroll
    for(int i=0;i<4;++i){const int row=i*8+(lane2>>3),ch=lane2&7; const u32x4 v=*(const u32x4*)(stg+row*64+ch*8); ATTN_STORE16(Ow+(long)row*OPITCH+ch*8,v);} }
  asm volatile("s_waitcnt lgkmcnt(0)\n\ts_barrier":::"memory");
  #undef DMA_K
  #undef DMA_V
  #undef CMASK
  #undef START
  #undef RESC
  #undef ROT
}
constexpr int ATTN_LDS_BYTES=LDS_BYTES;
#undef SBAR
#undef WAIT_BAR
}

#define LAS __attribute__((address_space(3)))
typedef unsigned short bf16;
typedef unsigned v4u __attribute__((ext_vector_type(4)));
typedef float f32x4 __attribute__((ext_vector_type(4)));
typedef short bf16x8 __attribute__((ext_vector_type(8)));
#define LDS_WAIT() asm volatile("s_waitcnt lgkmcnt(0)" ::: "memory")
#define VM_WAIT() asm volatile("s_waitcnt vmcnt(0)" ::: "memory")

constexpr int NWAVES = 8, NTHR = 512, GRID = 256;
constexpr int BATCH = 4, SEQ = 4096, T = BATCH * SEQ, DM = 1024, NH = 8, FF = 4096, DIN = 8208;
constexpr int NCHUNK = SEQ / 64, NITEM = BATCH * NH * NCHUNK;
constexpr float EPS = 1e-6f;
constexpr float QSCALE = 0.125f * 1.4426950408889634f;
constexpr int NPHASE = 13;
#ifndef PH_MASK
#define PH_MASK 0x1fff
#endif
#ifndef PROBE_DUP
#define PROBE_DUP 0
#endif
#ifndef PROBE_BAR2
#define PROBE_BAR2 0
#endif
#ifndef MK_PER_PHASE
#define MK_PER_PHASE 0
#endif

constexpr size_t MiB = 1u << 20;
constexpr size_t WS_ROPE = 1 * MiB, WS_IFG = 2 * MiB, WS_SS1 = 3 * MiB, WS_SS2 = 3 * MiB + 256 * 1024, WS_CHK = 3 * MiB + 512 * 1024, WS_LAM = 3 * MiB + 768 * 1024;
constexpr size_t WS_NST = 4 * MiB, WS_NST2 = 4 * MiB + 512 * 1024, WS_WTIF = 5 * MiB;
constexpr size_t WS_WTIN = 6 * MiB, WS_WTAB = 22 * MiB, WS_WTOUT = 26 * MiB, WS_WTFF1 = 30 * MiB, WS_WTFF2 = 38 * MiB;
constexpr size_t WS_XN = 46 * MiB, WS_QA = 78 * MiB, WS_KA = 110 * MiB, WS_VA = 142 * MiB, WS_QKM = 174 * MiB, WS_VM = 206 * MiB, WS_END = 238 * MiB;
constexpr size_t WS_UST = WS_KA;
constexpr size_t WS_Y = WS_KA;
constexpr size_t WS_HB = WS_QKM;
constexpr size_t WS_U = WS_XN;

struct Params {
    const float* x; const int* pos; const float* norm_mix_w; const float* w_in; const float* gate_b; const float* conv_w; const float* conv_b; const float* da_lambda;
    const float* subln_w; const float* ml_norm_w; const float* w_a; const float* w_b; const float* w_out; const float* norm_ffn_w; const float* w_ff1; const float* w_ff2; const float* final_w;
    float* out; unsigned char* ws; int ph_lo, ph_hi;
};

__device__ __forceinline__ float bf_lo_(unsigned w) { return __uint_as_float(w << 16); }
__device__ __forceinline__ float bf_hi_(unsigned w) { return __uint_as_float(w & 0xffff0000u); }
__device__ __forceinline__ float bf2f(bf16 v) { return __uint_as_float((unsigned)v << 16); }
__device__ __forceinline__ unsigned f2bf(float f) { unsigned u = __builtin_bit_cast(unsigned, f); return (u + 0x7fffu + ((u >> 16) & 1u)) >> 16; }
__device__ __forceinline__ unsigned pk2(float lo, float hi) { return f2bf(lo) | (f2bf(hi) << 16); }
__device__ __forceinline__ float sigm_(float x) { return 1.f / (1.f + __expf(-x)); }
__device__ __forceinline__ float wave_sum(float v) {
#pragma unroll
    for (int o = 1; o < 64; o <<= 1) v += __shfl_xor(v, o);
    return v;
}
__device__ __forceinline__ float wave_max(float v) {
#pragma unroll
    for (int o = 1; o < 64; o <<= 1) v = fmaxf(v, __shfl_xor(v, o));
    return v;
}

#define GAS __attribute__((address_space(1)))
typedef GAS unsigned gu32;
#define RLX_AGENT __ATOMIC_RELAXED, __HIP_MEMORY_SCOPE_AGENT
constexpr int CW_BAR = 4096;
#define XB_TMO      128
#define XB_XCNT(j)  (256  + 64 * (j))
#define XB_XSUB(j)  (1280 + 64 * (j))
#define XB_XGEN(j)  (2304 + 64 * (j))
#define XB_TOP      3328
#define XB_TOPGEN   3392
#define XCD_BAR_WORDS 3456
#define XB_SPIN_CAP (1u << 18)

__device__ __forceinline__ unsigned xb_ld(unsigned* p)              { return __hip_atomic_load(p, __ATOMIC_RELAXED, __HIP_MEMORY_SCOPE_AGENT); }
__device__ __forceinline__ unsigned xb_add(unsigned* p, unsigned v) { return __hip_atomic_fetch_add(p, v, __ATOMIC_RELAXED, __HIP_MEMORY_SCOPE_AGENT); }
__device__ __forceinline__ unsigned xb_xcc_id() { return (unsigned)__builtin_amdgcn_s_getreg((3 << 11) | 20) & 0xFu; }
#define XB_SPIN(cond, bar) do { unsigned _sp = 0; while (cond) { __builtin_amdgcn_s_sleep(1); \
    if ((++_sp & 255u) == 0u) { if (xb_ld(&(bar)[XB_TMO])) break; if (_sp > XB_SPIN_CAP) { atomicAdd(&(bar)[XB_TMO], 1u); break; } } } } while (0)

struct XcdBarrier {
    unsigned* bar; unsigned x;
    volatile LAS unsigned* st;
};

__device__ __forceinline__ XcdBarrier xcd_barrier_post(unsigned* bar, volatile LAS unsigned* st) {
    XcdBarrier b; b.bar = bar; b.x = xb_xcc_id(); b.st = st;
    if (threadIdx.x == 0) (void)xb_add(&bar[XB_XCNT(b.x)], 1u);
    return b;
}
__device__ __forceinline__ void xcd_barrier_complete(unsigned* bar, unsigned x, unsigned& nloc, unsigned& nx) {
    const unsigned G = gridDim.x * gridDim.y * gridDim.z;
    unsigned sum, cnt, mine, sp = 0u;
    for (;;) {
        sum = 0u; cnt = 0u; mine = 0u;
#pragma unroll
        for (unsigned j = 0; j < 16; ++j) { const unsigned c = xb_ld(&bar[XB_XCNT(j)]); sum += c; cnt += (c > 0u) ? 1u : 0u; mine = (j == x) ? c : mine; }
        if (sum == G) break;
        __builtin_amdgcn_s_sleep(1);
        if ((++sp & 255u) == 0u) { if (xb_ld(&bar[XB_TMO])) break; if (sp > XB_SPIN_CAP) { atomicAdd(&bar[XB_TMO], 1u); break; } }
    }
    nloc = mine > 0u ? mine : 1u; nx = cnt > 0u ? cnt : 1u;
}

__device__ __forceinline__ void xcd_barrier(const XcdBarrier& b) {
    asm volatile("s_waitcnt vmcnt(0)" ::: "memory");
    __syncthreads();
    if (threadIdx.x == 0) {
        unsigned* bar = b.bar;
        __builtin_amdgcn_s_waitcnt(0);
        unsigned nloc = b.st[0], nx = b.st[1];
        if (nloc == 0u) { xcd_barrier_complete(bar, b.x, nloc, nx); b.st[0] = nloc; b.st[1] = nx; }
        const unsigned old = xb_add(&bar[XB_XSUB(b.x)], 1u);
        const unsigned gen = old / nloc;
        if (old + 1u == (gen + 1u) * nloc) {
            __builtin_amdgcn_fence(__ATOMIC_RELEASE, "agent");
            asm volatile("s_waitcnt vmcnt(0)" ::: "memory");
            const unsigned og = xb_add(&bar[XB_TOP], 1u);
            const unsigned tg = og / nx;
            if (og + 1u == (tg + 1u) * nx) xb_add(&bar[XB_TOPGEN], 1u);
            else XB_SPIN(xb_ld(&bar[XB_TOPGEN]) == tg, bar);
            __builtin_amdgcn_fence(__ATOMIC_ACQUIRE, "agent");
            xb_add(&bar[XB_XGEN(b.x)], 1u);
            asm volatile("s_waitcnt vmcnt(0)" ::: "memory");
        } else {
            XB_SPIN(xb_ld(&bar[XB_XGEN(b.x)]) == gen, bar);
            __builtin_amdgcn_fence(__ATOMIC_ACQUIRE, "agent");
            asm volatile("s_waitcnt vmcnt(0)" ::: "memory");
        }
    }
    __syncthreads();
}


__device__ __forceinline__ void p0_transpose_item(const float* W, int ldw, int k0, int n_src0, int nvalid, bf16* WT, int dst_row0, int ldt, int kdst_off,
                                                  const float* ks, int ksmask, float kmul, LAS float* scr, int lane) {
#pragma unroll 8
    for (int i = 0; i < 32; ++i) { const int kk = 2 * i + (lane >> 5), n = lane & 31;
        float v = (n < nvalid) ? W[(size_t)(k0 + kk) * ldw + n_src0 + n] : 0.f;
        if (ks) v *= ks[(k0 + kk) & ksmask] * kmul;
        scr[kk * 33 + n] = v; }
    LDS_WAIT(); asm volatile("" ::: "memory");
    const int c = lane & 7;
#pragma unroll
    for (int j = 0; j < 4; ++j) { const int n = (lane >> 3) + 8 * j; const LAS float* s = scr + (8 * c) * 33 + n;
        v4u o; o.x = pk2(s[0 * 33], s[1 * 33]); o.y = pk2(s[2 * 33], s[3 * 33]); o.z = pk2(s[4 * 33], s[5 * 33]); o.w = pk2(s[6 * 33], s[7 * 33]);
        if (n < nvalid) *(v4u*)(WT + (size_t)(dst_row0 + n) * ldt + kdst_off + k0 + 8 * c) = o; }
    LDS_WAIT(); asm volatile("" ::: "memory");
}
__device__ __forceinline__ void p0_prologue(const Params& p, LAS unsigned char* lds, int vcu) {
    int tid_ = threadIdx.x; asm volatile("" : "+v"(tid_)); const int lane = tid_ & 63, wave = __builtin_amdgcn_readfirstlane(tid_ >> 6);
    unsigned char* ws = p.ws;
    LAS float* scr = (LAS float*)(lds + wave * 16384);
    const int gw = vcu * NWAVES + wave, NGW = GRID * NWAVES;
    bf16* WTIN = (bf16*)(ws + WS_WTIN); bf16* WTIF = (bf16*)(ws + WS_WTIF); bf16* WTAB = (bf16*)(ws + WS_WTAB); bf16* WTOUT = (bf16*)(ws + WS_WTOUT);
    bf16* WTFF1 = (bf16*)(ws + WS_WTFF1); bf16* WTFF2 = (bf16*)(ws + WS_WTFF2);
    constexpr int I_IN = 16 * 256, I_IF = 16, I_A = 16 * 32, I_B = 16 * 32, I_O = 16 * 32 * 2, I_1 = 16 * 128, I_2 = 64 * 32;
    constexpr int NITEMS = I_IN + I_IF + I_A + I_B + I_O + I_1 + I_2;
    for (int it = gw; it < NITEMS; it += NGW) {
        int r = it;
        if (r < I_IN) { const int kb = r / 256, nb = r % 256, n0 = nb * 32; const int src = n0 + (n0 >= 5120 ? 16 : 0);
            p0_transpose_item(p.w_in, DIN, kb * 64, src, 32, WTIN, n0, 1024, 0, nullptr, 0, 1.f, scr, lane); continue; } r -= I_IN;
        if (r < I_IF) { p0_transpose_item(p.w_in, DIN, r * 64, 5120, 16, WTIF, 0, 1024, 0, nullptr, 0, 1.f, scr, lane); continue; } r -= I_IF;
        if (r < I_A) { const int kb = r / 32, nb = r % 32; p0_transpose_item(p.w_a, 1024, kb * 64, nb * 32, 32, WTAB, nb * 32, 1024, 0, p.subln_w, 127, 0.8f, scr, lane); continue; } r -= I_A;
        if (r < I_B) { const int kb = r / 32, nb = r % 32; p0_transpose_item(p.w_b, 1024, kb * 64, nb * 32, 32, WTAB, 1024 + nb * 32, 1024, 0, p.ml_norm_w, 1023, 1.f, scr, lane); continue; } r -= I_B;
        if (r < I_O) { const int half = r / 512, q = r % 512, kb = q / 32, nb = q % 32; p0_transpose_item(p.w_out, 1024, kb * 64, nb * 32, 32, WTOUT, nb * 32, 2048, half * 1024, nullptr, 0, 1.f, scr, lane); continue; } r -= I_O;
        if (r < I_1) { const int kb = r / 128, nb = r % 128; p0_transpose_item(p.w_ff1, FF, kb * 64, nb * 32, 32, WTFF1, nb * 32, 1024, 0, p.norm_ffn_w, 1023, 1.f, scr, lane); continue; } r -= I_1;
        { const int kb = r / 32, nb = r % 32; p0_transpose_item(p.w_ff2, 1024, kb * 64, nb * 32, 32, WTFF2, nb * 32, FF, 0, nullptr, 0, 1.f, scr, lane); }
    }
    bf16* XN = (bf16*)(ws + WS_XN);
    for (int m = gw; m < T; m += NGW) {
        const f32x4* xr = (const f32x4*)(p.x + (size_t)m * DM) + lane; const f32x4* wr_ = (const f32x4*)p.norm_mix_w + lane;
        f32x4 v[4]; float s = 0.f;
#pragma unroll
        for (int j = 0; j < 4; ++j) { v[j] = xr[64 * j]; s += (v[j].x * v[j].x + v[j].y * v[j].y) + (v[j].z * v[j].z + v[j].w * v[j].w); }
        const float rstd = 1.f / sqrtf(wave_sum(s) * (1.f / DM) + EPS);
        unsigned long long* o8 = (unsigned long long*)(XN + (size_t)m * DM) + lane;
#pragma unroll
        for (int j = 0; j < 4; ++j) { const f32x4 w = wr_[64 * j]; o8[64 * j] = (unsigned long long)pk2(v[j].x * rstd * w.x, v[j].y * rstd * w.y) | ((unsigned long long)pk2(v[j].z * rstd * w.z, v[j].w * rstd * w.w) << 32); }
    }
    { const int g = blockIdx.x * NTHR + tid_;
        float* rope = (float*)(ws + WS_ROPE);
        for (int e = g; e < T * 8; e += GRID * NTHR) { const int t = e >> 3, i = e & 7;
            const float inv = (float)exp(-(double)i * (1.0 / 8.0) * 13.122363377404328);
            const float ang = (float)p.pos[t] * inv;
            double rev = (double)ang * 0.15915494309189535; rev -= floor(rev);
            const float rv = (float)rev;
            rope[t * 16 + i] = __builtin_amdgcn_cosf(rv); rope[t * 16 + 8 + i] = __builtin_amdgcn_sinf(rv); } }
    if (blockIdx.x == 0 && wave == 0) { const float* L = p.da_lambda; const float a = wave_sum(L[lane] * L[64 + lane]), b = wave_sum(L[128 + lane] * L[192 + lane]);
        if (lane == 0) *(float*)(ws + WS_LAM) = expf(a) - expf(b) + 0.2f; }
}

__device__ __forceinline__ void p1_gates(const Params& p, int vcu) {
    int tid_ = threadIdx.x; asm volatile("" : "+v"(tid_)); const int lane = tid_ & 63, wave = __builtin_amdgcn_readfirstlane(tid_ >> 6);
    const bf16* XN = (const bf16*)(p.ws + WS_XN); const bf16* WTIF = (const bf16*)(p.ws + WS_WTIF); float* IFG = (float*)(p.ws + WS_IFG);
    const int gw = vcu * NWAVES + wave, NGW = GRID * NWAVES;
    for (int it = gw; it < T / 16; it += NGW) {
        const bf16* ap = XN + (size_t)(it * 16 + (lane & 15)) * DM + (lane >> 4) * 8; const bf16* bp = WTIF + (size_t)(lane & 15) * DM + (lane >> 4) * 8;
        f32x4 acc = {0.f, 0.f, 0.f, 0.f};
#pragma unroll 8
        for (int kk = 0; kk < 32; ++kk) { const bf16x8 a = *(const bf16x8*)(ap + kk * 32), b = *(const bf16x8*)(bp + kk * 32); acc = __builtin_amdgcn_mfma_f32_16x16x32_bf16(a, b, acc, 0, 0, 0); }
        const int n = lane & 15; const float gb = p.gate_b[n];
#pragma unroll
        for (int r = 0; r < 4; ++r) { const int tok = it * 16 + (lane >> 4) * 4 + r; float v = acc[r] + gb;
            if (n >= 8) v = fminf(v, 0.f) - log1pf(__expf(-fabsf(v)));
            IFG[(size_t)tok * 16 + n] = v; }
    }
}

__device__ __forceinline__ void attn_phase(const Params& p, char* lds, int vcu, int nrep) {
    using abf = attn_body::bf16;
    {
        const abf* QA = (const abf*)(p.ws + WS_QA); const abf* KA = (const abf*)(p.ws + WS_KA); const abf* VA = (const abf*)(p.ws + WS_VA); abf* OATT = (abf*)p.out;
        const int bh = vcu >> 3, s = vcu & 7, b = bh >> 3, h = bh & 7;
#pragma unroll 1
        for (int su_ = 0; su_ < 8 * nrep; ++su_) { const int su = su_ & 7;
            const int qb = (su < 4) ? 15 - s : s, c = (su >> 1) & 1, hf = su & 1;
            attn_body::attn_unit<8>(b, h * 128 + c * 64, h * 128 + hf * 64, h * 256 + c * 128 + hf * 64, qb, QA, KA, VA, OATT, lds);
        }
    }
    VM_WAIT(); __syncthreads();
    {
        int tid = threadIdx.x; asm volatile("" : "+v"(tid));
        const int bh = vcu >> 3, s = vcu & 7, b = bh >> 3, h = bh & 7;
        const float lam = *(const float*)(p.ws + WS_LAM);
        const bf16* O = (const bf16*)p.out; bf16* OAN = (bf16*)(p.ws + WS_QA);
#pragma unroll 1
        for (int ps = 0; ps < 8; ++ps) {
            const int qb = (ps < 4) ? 15 - s : s;
            const int r = (ps & 3) * 64 + (tid >> 3), v0 = (tid & 7) * 16; const size_t t = (size_t)b * SEQ + qb * 256 + r;
            const v4u* o0 = (const v4u*)(O + t * 2048 + h * 256 + v0); const v4u* o1 = (const v4u*)(O + t * 2048 + h * 256 + 128 + v0);
            float d[16]; float ss = 0.f;
#pragma unroll
            for (int j = 0; j < 2; ++j) { const v4u a = o0[j], bb = o1[j];
#pragma unroll
                for (int e = 0; e < 4; ++e) { const float lo = bf_lo_(a[e]) - lam * bf_lo_(bb[e]), hi = bf_hi_(a[e]) - lam * bf_hi_(bb[e]); d[j * 8 + 2 * e] = lo; d[j * 8 + 2 * e + 1] = hi; ss += lo * lo + hi * hi; } }
            ss += __shfl_xor(ss, 1); ss += __shfl_xor(ss, 2); ss += __shfl_xor(ss, 4);
            const float rstd = 1.f / sqrtf(ss * (1.f / 128.f) + EPS);
            v4u w0, w1;
#pragma unroll
            for (int e = 0; e < 4; ++e) { w0[e] = pk2(d[2 * e] * rstd, d[2 * e + 1] * rstd); w1[e] = pk2(d[8 + 2 * e] * rstd, d[8 + 2 * e + 1] * rstd); }
            v4u* dst = (v4u*)(OAN + t * 1024 + h * 128 + v0); dst[0] = w0; dst[1] = w1;
        }
    }
}

typedef short s16x4 __attribute__((ext_vector_type(4)));
typedef short v4i16_t __attribute__((ext_vector_type(4)));
typedef float f32x16 __attribute__((ext_vector_type(16)));
typedef float f32x2_t __attribute__((ext_vector_type(2))); typedef __bf16 bf16x2_t __attribute__((ext_vector_type(2)));
__device__ __forceinline__ unsigned cvtpk2(float lo, float hi) { f32x2_t v = {lo, hi}; bf16x2_t b = __builtin_convertvector(v, bf16x2_t); return __builtin_bit_cast(unsigned, b); }
__device__ __forceinline__ s16x4 ml_vtr(const LAS unsigned char* p) { return __builtin_bit_cast(s16x4, __builtin_amdgcn_ds_read_tr16_b64_v4i16((LAS v4i16_t*)p)); }
__device__ __forceinline__ bf16x8 ml_cat(s16x4 lo, s16x4 hi) { return (bf16x8){lo[0], lo[1], lo[2], lo[3], hi[0], hi[1], hi[2], hi[3]}; }
__device__ __forceinline__ int ml_crow(int reg, int h) { return (reg & 3) + 8 * (reg >> 2) + 4 * h; }
constexpr int ML_P64 = 144, ML_P128 = 288;
constexpr float LOG2E = 1.4426950408889634f;

__device__ __forceinline__ void ml_conv8(const Params& p, int b, int c, int s, int ch0, float scale, float (&o)[8]) {
    const bf16* QKM = (const bf16*)(p.ws + WS_QKM);
    { const f32x4 b0 = *(const f32x4*)(p.conv_b + ch0), b1 = *(const f32x4*)(p.conv_b + ch0 + 4); o[0] = b0.x; o[1] = b0.y; o[2] = b0.z; o[3] = b0.w; o[4] = b1.x; o[5] = b1.y; o[6] = b1.z; o[7] = b1.w; }
#pragma unroll
    for (int j = 0; j < 4; ++j) { const int tt = c * 64 + s - 3 + j;
        if (tt >= 0) { const v4u raw = *(const v4u*)(QKM + ((size_t)b * SEQ + tt) * 1024 + ch0); const f32x4 w0 = *(const f32x4*)(p.conv_w + j * 1024 + ch0), w1 = *(const f32x4*)(p.conv_w + j * 1024 + ch0 + 4);
            o[0] += w0.x * bf_lo_(raw.x); o[1] += w0.y * bf_hi_(raw.x); o[2] += w0.z * bf_lo_(raw.y); o[3] += w0.w * bf_hi_(raw.y);
            o[4] += w1.x * bf_lo_(raw.z); o[5] += w1.y * bf_hi_(raw.z); o[6] += w1.z * bf_lo_(raw.w); o[7] += w1.w * bf_hi_(raw.w); } }
#pragma unroll
    for (int e = 0; e < 8; ++e) o[e] = o[e] * scale * __builtin_amdgcn_rcpf(1.f + __builtin_amdgcn_exp2f(-LOG2E * o[e]));
}
__device__ __forceinline__ v4u ml_pack8(const float (&o)[8], float m) { v4u w; w.x = cvtpk2(o[0] * m, o[1] * m); w.y = cvtpk2(o[2] * m, o[3] * m); w.z = cvtpk2(o[4] * m, o[5] * m); w.w = cvtpk2(o[6] * m, o[7] * m); return w; }

__device__ __forceinline__ void mlstm_a(const Params& p, LAS unsigned char* lds, int vcu) {
    int tid = threadIdx.x; asm volatile("" : "+v"(tid));
    const int lane = tid & 63, wave = __builtin_amdgcn_readfirstlane(tid >> 6), r = lane & 31, h2 = lane >> 5, q4 = (lane & 15) >> 2, p4 = lane & 3, blk = (lane >> 4) & 1;
    LAS unsigned char* KS = lds; LAS unsigned char* VL = lds + 9216; LAS float* wsl = (LAS float*)(lds + 9216 + 18432);
    float* UST = (float*)(p.ws + WS_UST); float* NST = (float*)(p.ws + WS_NST); float* CHK = (float*)(p.ws + WS_CHK); const float* IFG = (const float*)(p.ws + WS_IFG);
    const bf16* VM = (const bf16*)(p.ws + WS_VM);
#pragma unroll 1
    for (int item = vcu * 8; item < vcu * 8 + 8; ++item) {
        const int bh = item >> 6, c = item & 63, b = bh >> 3, h = bh & 7; const size_t t0 = (size_t)b * SEQ + c * 64;
        if (wave == 0) { const float ig = IFG[(t0 + lane) * 16 + h], lf = IFG[(t0 + lane) * 16 + 8 + h]; float bs = lf;
#pragma unroll
            for (int o = 1; o < 64; o <<= 1) { const float t = __shfl_up(bs, o); if (lane >= o) bs += t; }
            const float bL = __shfl(bs, 63), wl = bL - bs + ig, mloc = wave_max(wl);
            wsl[lane] = __builtin_amdgcn_exp2f((wl - mloc) * LOG2E); if (lane == 0) { CHK[item * 4 + 0] = mloc; CHK[item * 4 + 1] = bL; } }
        __syncthreads();
        { const int s = tid >> 3, ch8 = (tid & 7) * 8; float o[8]; ml_conv8(p, b, c, s, 512 + h * 64 + ch8, 1.f, o);
            *(LAS v4u*)(KS + s * ML_P64 + ch8 * 2) = ml_pack8(o, wsl[s]); }
#pragma unroll
        for (int i = 0; i < 2; ++i) { const int pc = tid + i * NTHR, s = pc >> 4, v8 = (pc & 15) * 8;
            *(LAS v4u*)(VL + s * ML_P128 + v8 * 2) = *(const v4u*)(VM + (t0 + s) * 1024 + h * 128 + v8); }
        __syncthreads();
        const int vb = wave >> 1, db = wave & 1; f32x16 acc = {};
#pragma unroll
        for (int ks = 0; ks < 4; ++ks) {
            const LAS unsigned char* ap = VL + (16 * ks + 8 * h2 + q4) * ML_P128 + (32 * vb + 16 * blk) * 2 + 8 * p4;
            const LAS unsigned char* bp = KS + (16 * ks + 8 * h2 + q4) * ML_P64 + (32 * db + 16 * blk) * 2 + 8 * p4;
            const bf16x8 a = ml_cat(ml_vtr(ap), ml_vtr(ap + 4 * ML_P128)), bb = ml_cat(ml_vtr(bp), ml_vtr(bp + 4 * ML_P64));
            acc = __builtin_amdgcn_mfma_f32_32x32x16_bf16(a, bb, acc, 0, 0, 0); }
        float* up = UST + (size_t)item * 8192 + 32 * db + r;
#pragma unroll
        for (int i = 0; i < 16; ++i) up[(32 * vb + ml_crow(i, h2)) * 64] = acc[i];
        if (tid < 64) { float n = 0.f;
#pragma unroll 8
            for (int s = 0; s < 64; ++s) n += bf2f(*(const LAS bf16*)(KS + s * ML_P64 + tid * 2));
            NST[item * 64 + tid] = n; }
    }
}
__device__ __forceinline__ void mlstm_b(const Params& p) {
    const float* UST = (const float*)(p.ws + WS_UST); const float* NST = (const float*)(p.ws + WS_NST); float* CHK = (float*)(p.ws + WS_CHK); bf16* CT = (bf16*)p.out;
    constexpr int PER = 8192 + 64, TOTAL = BATCH * NH * PER;
    for (int e = blockIdx.x * NTHR + threadIdx.x; e < TOTAL; e += GRID * NTHR) {
        const int bh = e / PER, idx = e % PER; const bool isn = idx >= 8192;
        const float* src = isn ? NST + (size_t)bh * 64 * 64 + (idx - 8192) : UST + (size_t)bh * 64 * 8192 + idx; const int stride = isn ? 64 : 8192;
        bf16* dstb = CT + (size_t)bh * 64 * 8192 + idx; float* dstf = (float*)(p.ws + WS_NST2) + (size_t)bh * 64 * 64 + (idx - 8192);
        float C = 0.f, m = 0.f;
#pragma unroll 4
        for (int c = 0; c < NCHUNK; ++c) { const int item = bh * 64 + c; const float mloc = CHK[item * 4 + 0], g = CHK[item * 4 + 1];
            const float u = src[(size_t)c * stride];
            if (isn) dstf[(size_t)c * 64] = C; else dstb[(size_t)c * 8192] = (bf16)f2bf(C);
            if (idx == 0) CHK[item * 4 + 2] = m;
            const float mn = fmaxf(g + m, mloc); C = __expf(g + m - mn) * C + __expf(mloc - mn) * u; m = mn; }
    }
}
__device__ __forceinline__ void mlstm_c(const Params& p, LAS unsigned char* lds, int vcu) {
    int tid = threadIdx.x; asm volatile("" : "+v"(tid));
    const int lane = tid & 63, wave = __builtin_amdgcn_readfirstlane(tid >> 6), r = lane & 31, h2 = lane >> 5, q4 = (lane & 15) >> 2, p4 = lane & 3, blk = (lane >> 4) & 1;
    LAS unsigned char* QL = lds; LAS unsigned char* KL = lds + 9216; LAS unsigned char* VL = lds + 18432; LAS unsigned char* CTL = lds + 36864; LAS unsigned char* OUTL = lds + 55296;
    LAS float* fa = (LAS float*)(lds + 72704); LAS float* bt2 = fa; LAS float* cs2 = fa + 64; LAS float* inl = fa + 128; LAS float* emt = fa + 192; LAS float* nl = fa + 256; LAS float* part = fa + 320;
    const float* NST = (const float*)(p.ws + WS_NST2); const float* CHK = (const float*)(p.ws + WS_CHK); const float* IFG = (const float*)(p.ws + WS_IFG);
    const bf16* CT = (const bf16*)p.out; const bf16* VM = (const bf16*)(p.ws + WS_VM); bf16* OB = (bf16*)(p.ws + WS_VM);
#pragma unroll 1
    for (int item = vcu * 8; item < vcu * 8 + 8; ++item) {
        const int bh = item >> 6, c = item & 63, b = bh >> 3, h = bh & 7; const size_t t0 = (size_t)b * SEQ + c * 64;
        __syncthreads();
        if (wave == 7) { const float mc = CHK[item * 4 + 2]; const float ig = IFG[(t0 + lane) * 16 + h], lf = IFG[(t0 + lane) * 16 + 8 + h]; float bs = lf;
#pragma unroll
            for (int o = 1; o < 64; o <<= 1) { const float t = __shfl_up(bs, o); if (lane >= o) bs += t; }
            float pm = ig - bs;
#pragma unroll
            for (int o = 1; o < 64; o <<= 1) { const float t = __shfl_up(pm, o); if (lane >= o) pm = fmaxf(pm, t); }
            const float mt = bs + fmaxf(pm, mc);
            bt2[lane] = (bs - mt) * LOG2E; cs2[lane] = (ig - bs) * LOG2E; inl[lane] = __builtin_amdgcn_exp2f((bs + mc - mt) * LOG2E); emt[lane] = __builtin_amdgcn_exp2f(-mt * LOG2E); }
        { const int s = tid >> 3, ch8 = (tid & 7) * 8; float o[8];
            ml_conv8(p, b, c, s, h * 64 + ch8, 0.125f, o); *(LAS v4u*)(QL + s * ML_P64 + ch8 * 2) = ml_pack8(o, 1.f);
            ml_conv8(p, b, c, s, 512 + h * 64 + ch8, 1.f, o); *(LAS v4u*)(KL + s * ML_P64 + ch8 * 2) = ml_pack8(o, 1.f); }
#pragma unroll
        for (int i = 0; i < 2; ++i) { const int pc = tid + i * NTHR;
            { const int s = pc >> 4, v8 = (pc & 15) * 8; *(LAS v4u*)(VL + s * ML_P128 + v8 * 2) = *(const v4u*)(VM + (t0 + s) * 1024 + h * 128 + v8); }
            { const int v = pc >> 3, d8 = (pc & 7) * 8; *(LAS v4u*)(CTL + v * ML_P64 + d8 * 2) = *(const v4u*)(CT + (size_t)item * 8192 + v * 64 + d8); } }
        if (tid < 64) nl[tid] = NST[item * 64 + tid];
        __syncthreads();
        const int tb = wave & 1, vb = wave >> 1, t = 32 * tb + r;
        bf16x8 qf[4];
#pragma unroll
        for (int ks = 0; ks < 4; ++ks) qf[ks] = *(const LAS bf16x8*)(QL + t * ML_P64 + (16 * ks + 8 * h2) * 2);
        f32x16 X[2]; X[0] = (f32x16){}; X[1] = (f32x16){};
#pragma unroll
        for (int sb = 0; sb < 2; ++sb)
#pragma unroll
            for (int ks = 0; ks < 4; ++ks) { const bf16x8 kf = *(const LAS bf16x8*)(KL + (32 * sb + r) * ML_P64 + (16 * ks + 8 * h2) * 2);
                X[sb] = __builtin_amdgcn_mfma_f32_32x32x16_bf16(kf, qf[ks], X[sb], 0, 0, 0); }
        const float btl = bt2[t]; float dsum = 0.f;
#pragma unroll
        for (int sb = 0; sb < 2; ++sb)
#pragma unroll
            for (int g = 0; g < 4; ++g) { const f32x4 cs4 = *(const LAS f32x4*)(cs2 + 32 * sb + 8 * g + 4 * h2);
#pragma unroll
                for (int e = 0; e < 4; ++e) { const int s = 32 * sb + 8 * g + 4 * h2 + e; const float w = (s <= t) ? __builtin_amdgcn_exp2f(btl + cs4[e]) : 0.f;
                    const float x = X[sb][4 * g + e] * w; X[sb][4 * g + e] = x; dsum += x; } }
        dsum += __shfl_xor(dsum, 32);
        float qn = 0.f;
#pragma unroll
        for (int ks = 0; ks < 4; ++ks) { const f32x4 n0 = *(const LAS f32x4*)(nl + 16 * ks + 8 * h2), n1 = *(const LAS f32x4*)(nl + 16 * ks + 8 * h2 + 4); const bf16x8 q = qf[ks];
            qn += bf2f((bf16)q[0]) * n0.x + bf2f((bf16)q[1]) * n0.y + bf2f((bf16)q[2]) * n0.z + bf2f((bf16)q[3]) * n0.w + bf2f((bf16)q[4]) * n1.x + bf2f((bf16)q[5]) * n1.y + bf2f((bf16)q[6]) * n1.z + bf2f((bf16)q[7]) * n1.w; }
        qn += __shfl_xor(qn, 32);
        f32x16 acc1 = {}, acc2 = {};
#pragma unroll
        for (int sb = 0; sb < 2; ++sb)
#pragma unroll
            for (int sp = 0; sp < 2; ++sp) {
                const LAS unsigned char* ap = VL + (32 * sb + 16 * sp + 4 * h2 + q4) * ML_P128 + (32 * vb + 16 * blk) * 2 + 8 * p4;
                const bf16x8 a = ml_cat(ml_vtr(ap), ml_vtr(ap + 8 * ML_P128));
                v4u pk; pk.x = cvtpk2(X[sb][8 * sp + 0], X[sb][8 * sp + 1]); pk.y = cvtpk2(X[sb][8 * sp + 2], X[sb][8 * sp + 3]); pk.z = cvtpk2(X[sb][8 * sp + 4], X[sb][8 * sp + 5]); pk.w = cvtpk2(X[sb][8 * sp + 6], X[sb][8 * sp + 7]);
                acc1 = __builtin_amdgcn_mfma_f32_32x32x16_bf16(a, __builtin_bit_cast(bf16x8, pk), acc1, 0, 0, 0); }
#pragma unroll
        for (int ks = 0; ks < 4; ++ks) { const bf16x8 a = *(const LAS bf16x8*)(CTL + (32 * vb + r) * ML_P64 + (16 * ks + 8 * h2) * 2);
            acc2 = __builtin_amdgcn_mfma_f32_32x32x16_bf16(a, qf[ks], acc2, 0, 0, 0); }
        const float inter = inl[t], den = dsum + inter * qn, rden = 1.f / fmaxf(fabsf(den), emt[t]);
        float ss = 0.f;
#pragma unroll
        for (int i = 0; i < 16; ++i) { const float x = (acc1[i] + inter * acc2[i]) * rden; acc1[i] = x; ss += x * x; }
        ss += __shfl_xor(ss, 32);
        if (h2 == 0) part[vb * 64 + t] = ss;
        __syncthreads();
        const float rstd = 1.f / sqrtf(((part[t] + part[64 + t]) + (part[128 + t] + part[192 + t])) * (1.f / 128.f) + EPS);
#pragma unroll
        for (int g = 0; g < 4; ++g) { typedef unsigned u32x2v __attribute__((ext_vector_type(2))); u32x2v w; w.x = cvtpk2(acc1[4 * g] * rstd, acc1[4 * g + 1] * rstd); w.y = cvtpk2(acc1[4 * g + 2] * rstd, acc1[4 * g + 3] * rstd);
            *(LAS u32x2v*)(OUTL + t * 272 + (32 * vb + 8 * g + 4 * h2) * 2) = w; }
        __syncthreads();
#pragma unroll
        for (int i = 0; i < 2; ++i) { const int pc = tid + i * NTHR, tr = pc >> 4, v8 = (pc & 15) * 8;
            *(v4u*)(OB + (t0 + tr) * 1024 + h * 128 + v8) = *(const LAS v4u*)(OUTL + tr * 272 + v8 * 2); }
    }
}

__device__ __forceinline__ void final_norm(const Params& p, int vcu) {
    int tid_ = threadIdx.x; asm volatile("" : "+v"(tid_)); const int lane = tid_ & 63, wave = __builtin_amdgcn_readfirstlane(tid_ >> 6);
    const float* SS2 = (const float*)(p.ws + WS_SS2); const int gw = vcu * NWAVES + wave, NGW = GRID * NWAVES;
    for (int m = gw; m < T; m += NGW) {
        const f32x4 q = *(const f32x4*)(SS2 + (size_t)m * 4); const float rstd = 1.f / sqrtf(((q.x + q.y) + (q.z + q.w)) * (1.f / DM) + EPS);
        f32x4* xr = (f32x4*)(p.out + (size_t)m * DM) + lane; const f32x4* wr_ = (const f32x4*)p.final_w + lane;
#pragma unroll
        for (int j = 0; j < 4; ++j) { const f32x4 v = xr[64 * j], w = wr_[64 * j]; xr[64 * j] = v * rstd * w; }
    }
}

constexpr int LDS_BYTES = 147456;
__global__ void __launch_bounds__(NTHR, 2) mk_fwd(Params p) {
    extern __shared__ __attribute__((aligned(16))) unsigned char lds_raw[];
    LAS unsigned char* lds = (LAS unsigned char*)lds_raw;
    const int tid = threadIdx.x;
    const int bx = blockIdx.x, vcu = (bx % 8) * (GRID / 8) + bx / 8;
    unsigned char* ws = p.ws;
    bf16* XN = (bf16*)(ws + WS_XN); bf16* WTIN = (bf16*)(ws + WS_WTIN);
    const int lo = p.ph_lo, hi = p.ph_hi;
    volatile LAS unsigned* MISC = (volatile LAS unsigned*)(lds + LDS_BYTES - 64);
    if (tid < 16) MISC[tid] = 0u;
    __syncthreads();
    XcdBarrier bar; bar.bar = (unsigned*)(ws) + CW_BAR; bar.x = 0; bar.st = nullptr;
    if (hi - lo > 1) bar = xcd_barrier_post((unsigned*)(ws) + CW_BAR, MISC);
#define IN(k) (lo <= (k) && (k) < hi)
#define SEAM(k) do { if (IN(k) && IN((k) + 1)) { xcd_barrier(bar); if (PROBE_BAR2) xcd_barrier(bar); } } while (0)
#define DUP(k) ((PROBE_DUP >> (k)) & 1)
#if (PH_MASK >> 0) & 1
        if (IN(0)) { p0_prologue(p, lds, vcu); if (DUP(0)) { p0_prologue(p, lds, vcu); } } SEAM(0);
#endif
#if (PH_MASK >> 1) & 1
        if (IN(1)) { {
            pg8::Gemm g{XN, WTIN, T, 5120, DM, nullptr, 1 << 30}; pg8::StaticOrder S; S.init(T, 5120, GRID, bx);
            pg8::EpiInProj E{(bf16*)(ws + WS_QA), (size_t)T * 1024, (const float*)(ws + WS_ROPE), QSCALE};
            pg8::gemm_phase<pg8::EpiInProj, pg8::StaticOrder, true, true>(lds, g, S, E);
            p1_gates(p, vcu);
        } if (DUP(1)) { {
            pg8::Gemm g{XN, WTIN, T, 5120, DM, nullptr, 1 << 30}; pg8::StaticOrder S; S.init(T, 5120, GRID, bx);
            pg8::EpiInProj E{(bf16*)(ws + WS_QA), (size_t)T * 1024, (const float*)(ws + WS_ROPE), QSCALE};
            pg8::gemm_phase<pg8::EpiInProj, pg8::StaticOrder, true, true>(lds, g, S, E);
            p1_gates(p, vcu);
        } } } SEAM(1);
#endif
#if (PH_MASK >> 2) & 1
        if (IN(2)) { attn_phase(p, (char*)lds_raw, vcu, DUP(2) ? 2 : 1); } SEAM(2);
#endif
#if (PH_MASK >> 3) & 1
        if (IN(3)) { mlstm_a(p, lds, vcu); if (DUP(3)) { mlstm_a(p, lds, vcu); } } SEAM(3);
#endif
#if (PH_MASK >> 4) & 1
        if (IN(4)) { mlstm_b(p); if (DUP(4)) { mlstm_b(p); } } SEAM(4);
#endif
#if (PH_MASK >> 5) & 1
        if (IN(5)) { mlstm_c(p, lds, vcu); } SEAM(5);
#endif
#if (PH_MASK >> 6) & 1
        if (IN(6)) { {
            pg8::Gemm g{XN, WTIN + (size_t)5120 * 1024, T, 1024, DM, nullptr, 1 << 30}; pg8::StaticOrder S; S.init(T, 1024, GRID, bx);
            pg8::EpiSigMul E{(bf16*)(ws + WS_VM), 1024};
            pg8::gemm_phase<pg8::EpiSigMul, pg8::StaticOrder, true, true>(lds, g, S, E);
        } } SEAM(6);
#endif
#if (PH_MASK >> 7) & 1
        if (IN(7)) { {
            pg8::Gemm g{(const bf16*)(ws + WS_QA), (const bf16*)(ws + WS_WTAB), T, 2048, DM, (const bf16*)(ws + WS_VM), 4}; pg8::StaticOrder S; S.init(T, 2048, GRID, bx);
            pg8::EpiBf16<0> E{(bf16*)(ws + WS_Y), 2048, nullptr, 0, 0, 1.f};
            pg8::gemm_phase<pg8::EpiBf16<0>, pg8::StaticOrder, true, true>(lds, g, S, E);
        } if (DUP(7)) { {
            pg8::Gemm g{(const bf16*)(ws + WS_QA), (const bf16*)(ws + WS_WTAB), T, 2048, DM, (const bf16*)(ws + WS_VM), 4}; pg8::StaticOrder S; S.init(T, 2048, GRID, bx);
            pg8::EpiBf16<0> E{(bf16*)(ws + WS_Y), 2048, nullptr, 0, 0, 1.f};
            pg8::gemm_phase<pg8::EpiBf16<0>, pg8::StaticOrder, true, true>(lds, g, S, E);
        } } } SEAM(7);
#endif
#if (PH_MASK >> 8) & 1
        if (IN(8)) { {
            pg8::Gemm g{XN, WTIN + (size_t)6144 * 1024, T, 2048, DM, nullptr, 1 << 30}; pg8::StaticOrder S; S.init(T, 2048, GRID, bx);
            pg8::EpiSigMul E{(bf16*)(ws + WS_Y), 2048};
            pg8::gemm_phase<pg8::EpiSigMul, pg8::StaticOrder, true, true>(lds, g, S, E);
        } } SEAM(8);
#endif
#if (PH_MASK >> 9) & 1
        if (IN(9)) { {
            pg8::Gemm g{(const bf16*)(ws + WS_Y), (const bf16*)(ws + WS_WTOUT), T, 1024, 2048, nullptr, 1 << 30}; pg8::StaticOrder S; S.init(T, 1024, GRID, bx);
            pg8::EpiRes E{p.x, p.out, (bf16*)(ws + WS_HB), (float*)(ws + WS_SS1)};
            pg8::gemm_phase<pg8::EpiRes, pg8::StaticOrder, false, true>(lds, g, S, E);
        } if (DUP(9)) { {
            pg8::Gemm g{(const bf16*)(ws + WS_Y), (const bf16*)(ws + WS_WTOUT), T, 1024, 2048, nullptr, 1 << 30}; pg8::StaticOrder S; S.init(T, 1024, GRID, bx);
            pg8::EpiRes E{p.x, p.out, (bf16*)(ws + WS_HB), (float*)(ws + WS_SS1)};
            pg8::gemm_phase<pg8::EpiRes, pg8::StaticOrder, false, true>(lds, g, S, E);
        } } } SEAM(9);
#endif
#if (PH_MASK >> 10) & 1
        if (IN(10)) { {
            pg8::Gemm g{(const bf16*)(ws + WS_HB), (const bf16*)(ws + WS_WTFF1), T, FF, DM, nullptr, 1 << 30}; pg8::StaticOrder S; S.init(T, FF, GRID, bx);
            pg8::EpiFF1 E{(bf16*)(ws + WS_U), FF, (const float*)(ws + WS_SS1), EPS};
            pg8::gemm_phase<pg8::EpiFF1, pg8::StaticOrder, true, true>(lds, g, S, E);
        } if (DUP(10)) { {
            pg8::Gemm g{(const bf16*)(ws + WS_HB), (const bf16*)(ws + WS_WTFF1), T, FF, DM, nullptr, 1 << 30}; pg8::StaticOrder S; S.init(T, FF, GRID, bx);
            pg8::EpiFF1 E{(bf16*)(ws + WS_U), FF, (const float*)(ws + WS_SS1), EPS};
            pg8::gemm_phase<pg8::EpiFF1, pg8::StaticOrder, true, true>(lds, g, S, E);
        } } } SEAM(10);
#endif
#if (PH_MASK >> 11) & 1
        if (IN(11)) { {
            pg8::Gemm g{(const bf16*)(ws + WS_U), (const bf16*)(ws + WS_WTFF2), T, 1024, FF, nullptr, 1 << 30}; pg8::StaticOrder S; S.init(T, 1024, GRID, bx);
            pg8::EpiRes E{p.out, p.out, nullptr, (float*)(ws + WS_SS2)};
            pg8::gemm_phase<pg8::EpiRes, pg8::StaticOrder, false, true>(lds, g, S, E);
        } } SEAM(11);
#endif
#if (PH_MASK >> 12) & 1
        if (IN(12)) { final_norm(p, vcu); } SEAM(12);
#endif
#undef IN
#undef SEAM
}

extern "C" void kernel_launch(void* const* d_in, const int* in_sizes, int n_in, void* d_out, int out_size, void* d_ws, size_t ws_size, hipStream_t stream) {
    static int ready = 0;
    if (!ready) {
        if (n_in != 17 || in_sizes[0] != T * DM || out_size != T * DM || ws_size < WS_END) { fprintf(stderr, "kernel_launch: unexpected shapes (n_in %d in0 %d out %d ws %zu)\n", n_in, n_in > 0 ? in_sizes[0] : -1, out_size, ws_size); ready = -1; return; }
        if (hipFuncSetAttribute((const void*)mk_fwd, hipFuncAttributeMaxDynamicSharedMemorySize, LDS_BYTES) != hipSuccess) { fprintf(stderr, "kernel_launch: hipFuncSetAttribute failed\n"); ready = -1; return; }
        int per_cu = 0; (void)hipOccupancyMaxActiveBlocksPerMultiprocessor(&per_cu, (const void*)mk_fwd, NTHR, LDS_BYTES); (void)hipGetLastError();
        int dev = 0, cus = 0; (void)hipGetDevice(&dev); (void)hipDeviceGetAttribute(&cus, hipDeviceAttributeMultiprocessorCount, dev);
        if (per_cu < 1 || cus < GRID) fprintf(stderr, "kernel_launch: note: occupancy %d blocks/CU, %d CUs (need 1 x %d)\n", per_cu, cus, GRID);
        ready = 1;
    }
    if (ready < 0) return;
    Params p{};
    p.x = (const float*)d_in[0]; p.pos = (const int*)d_in[1]; p.norm_mix_w = (const float*)d_in[2]; p.w_in = (const float*)d_in[3]; p.gate_b = (const float*)d_in[4];
    p.conv_w = (const float*)d_in[5]; p.conv_b = (const float*)d_in[6]; p.da_lambda = (const float*)d_in[7]; p.subln_w = (const float*)d_in[8]; p.ml_norm_w = (const float*)d_in[9];
    p.w_a = (const float*)d_in[10]; p.w_b = (const float*)d_in[11]; p.w_out = (const float*)d_in[12]; p.norm_ffn_w = (const float*)d_in[13]; p.w_ff1 = (const float*)d_in[14];
    p.w_ff2 = (const float*)d_in[15]; p.final_w = (const float*)d_in[16]; p.out = (float*)d_out; p.ws = (unsigned char*)d_ws;
#if MK_PER_PHASE
    for (int ph = 0; ph < NPHASE; ++ph) { p.ph_lo = ph; p.ph_hi = ph + 1; hipLaunchKernelGGL(mk_fwd, dim3(GRID), dim3(NTHR), LDS_BYTES, stream, p); }
#else
    if (hipMemsetAsync(d_ws, 0, 1 * MiB, stream) != hipSuccess) { fprintf(stderr, "kernel_launch: memset of the control words failed\n"); return; }
    p.ph_lo = 0; p.ph_hi = NPHASE; void* args[] = {&p};
    hipError_t e = hipLaunchCooperativeKernel((const void*)mk_fwd, dim3(GRID), dim3(NTHR), args, LDS_BYTES, stream);
    if (e != hipSuccess) fprintf(stderr, "cooperative launch failed: %s\n", hipGetErrorString(e));
#endif
}
```
